# Optimizing an MI355X kernel written in HIP

```python
import math
import jax, jax.numpy as jnp
from jax import lax
import numpy as np

D_MODEL = 1024
BATCH = 2
SEQ = 16384
DEPTH = 2

N_HEADS = 8
QK_NOPE = 128
QK_ROPE = 64
V_HEAD = 128
Q_LORA = 384
KV_LORA = 256
ROPE_THETA = 10000.0
Q_BLOCK = 128

POOL_WINDOWS = (2, 4, 8, 16)
POOL_GROUPS = 4
POOL_GROUP_IN = 128
POOL_WIDTH = POOL_GROUPS * POOL_GROUP_IN
POOL_GROUP_OUT = D_MODEL // POOL_GROUPS

IN_COLS = Q_LORA + KV_LORA + QK_ROPE + POOL_WIDTH + 2 * D_MODEL

N_EXPERTS = 32
TOP_K = 4
D_FF = 1024
SWIGLU_LIMIT = 7.0
SWIGLU_ALPHA = 1.702
EXPERT_BLOCK = 128

EPS = 1e-6
N_MOD = 6

kernel_name = "hybrid_mla_pool_moe_adaln"


def rmsnorm(x, g):
    xf = x.astype(jnp.float32)
    inv = lax.rsqrt(jnp.mean(xf * xf, axis=-1, keepdims=True) + EPS)
    return (xf * inv).astype(x.dtype) * g


def rope_tables(positions):
    half = QK_ROPE // 2
    inv_freq = ROPE_THETA ** (-jnp.arange(half, dtype=jnp.float32) / half)
    ang = positions.astype(jnp.float32)[..., None] * inv_freq
    return jnp.cos(ang), jnp.sin(ang)


def apply_rope(x, cos, sin):
    x1, x2 = jnp.split(x, 2, axis=-1)
    cos = cos.astype(x.dtype)
    sin = sin.astype(x.dtype)
    return jnp.concatenate([x1 * cos - x2 * sin, x2 * cos + x1 * sin], axis=-1)


def causal_block_attention(q, k, v):
    B, S, H, Dqk = q.shape
    n_blk = S // Q_BLOCK
    scale = 1.0 / math.sqrt(QK_NOPE + QK_ROPE)
    qb = q.reshape(B, n_blk, Q_BLOCK, H, Dqk).transpose(1, 0, 2, 3, 4)
    kpos = jnp.arange(S)

    def one_block(args):
        i, qi = args
        s = jnp.einsum('bqhd,bkhd->bhqk', qi, k).astype(jnp.float32) * scale
        qpos = i * Q_BLOCK + jnp.arange(Q_BLOCK)
        mask = kpos[None, :] <= qpos[:, None]
        s = jnp.where(mask[None, None], s, jnp.finfo(jnp.float32).min)
        p = jax.nn.softmax(s, axis=-1).astype(v.dtype)
        return jnp.einsum('bhqk,bkhd->bqhd', p, v)

    o = lax.map(one_block, (jnp.arange(n_blk), qb))
    return o.transpose(1, 0, 2, 3, 4).reshape(B, S, H * v.shape[-1])


def mla_branch(c_q, c_kv, k_rope_raw, cos, sin, q_norm, w_uq, kv_norm, w_ukv):
    B, S, _ = c_q.shape
    q = rmsnorm(c_q, q_norm) @ w_uq
    q = q.reshape(B, S, N_HEADS, QK_NOPE + QK_ROPE)
    q_nope, q_rope = q[..., :QK_NOPE], q[..., QK_NOPE:]
    q_rope = apply_rope(q_rope, cos[:, :, None, :], sin[:, :, None, :])
    kv = (rmsnorm(c_kv, kv_norm) @ w_ukv).reshape(B, S, N_HEADS, QK_NOPE + V_HEAD)
    k_nope, v = kv[..., :QK_NOPE], kv[..., QK_NOPE:]
    k_rope = apply_rope(k_rope_raw, cos, sin)[:, :, None, :]
    k = jnp.concatenate([k_nope, jnp.broadcast_to(k_rope, (B, S, N_HEADS, QK_ROPE))], axis=-1)
    qf = jnp.concatenate([q_nope, q_rope], axis=-1)
    return causal_block_attention(qf, k, v)


def pool_branch(u, w_pool, pool_scale):
    B, S, _ = u.shape
    ug = u.reshape(B, S, POOL_GROUPS, POOL_GROUP_IN)
    uf = ug.astype(jnp.float32)
    cs = jnp.cumsum(uf, axis=1)
    cs_pad = jnp.concatenate([jnp.zeros((B, 1, POOL_GROUPS, POOL_GROUP_IN), jnp.float32), cs], axis=1)
    t = jnp.arange(S, dtype=jnp.float32)
    diffs = []
    for g, w in enumerate(POOL_WINDOWS):
        upper = cs_pad[:, 1:, g]
        lower = jnp.pad(cs_pad[:, :S + 1 - w, g], ((0, 0), (w - 1, 0), (0, 0)))
        count = jnp.minimum(t + 1.0, float(w))[None, :, None]
        diffs.append((upper - lower) / count - uf[:, :, g])
    p = jnp.stack(diffs, axis=2).astype(u.dtype)
    out = jnp.einsum('bsgc,gcd->bsgd', p, w_pool) * pool_scale
    return out.reshape(B, S, D_MODEL)


def moe_ffn(h, w_router, b_router, w_gu, b_gu, w_down, b_down):
    B, S, D = h.shape
    T = B * S
    xt = h.reshape(T, D)
    logits = (xt @ w_router + b_router).astype(jnp.float32)
    top_val, top_idx = lax.top_k(logits, TOP_K)
    top_w = jax.nn.softmax(top_val, axis=-1).astype(h.dtype)

    n_assign = T * TOP_K
    flat_e = top_idx.reshape(-1)
    flat_tok = jnp.repeat(jnp.arange(T, dtype=jnp.int32), TOP_K)
    flat_w = top_w.reshape(-1)
    order = jnp.argsort(flat_e, stable=True)
    e_sorted, tok_sorted, w_sorted = flat_e[order], flat_tok[order], flat_w[order]

    counts = jnp.bincount(flat_e, length=N_EXPERTS)
    starts = jnp.cumsum(counts) - counts
    padded = (counts + EXPERT_BLOCK - 1) // EXPERT_BLOCK * EXPERT_BLOCK
    pad_ends = jnp.cumsum(padded)
    pad_starts = pad_ends - padded
    dest = pad_starts[e_sorted] + (jnp.arange(n_assign) - starts[e_sorted])

    n_blocks = (n_assign + EXPERT_BLOCK - 1) // EXPERT_BLOCK + N_EXPERTS
    n_slots = n_blocks * EXPERT_BLOCK
    slot_tok = jnp.full((n_slots,), T, jnp.int32).at[dest].set(tok_sorted)
    slot_w = jnp.zeros((n_slots,), h.dtype).at[dest].set(w_sorted)
    block_e = jnp.minimum(
        jnp.searchsorted(pad_ends, jnp.arange(n_blocks) * EXPERT_BLOCK, side='right'), N_EXPERTS - 1)
    x_pad = jnp.concatenate([xt, jnp.zeros((1, D), xt.dtype)], axis=0)

    def expert_block(args):
        tok, wt, e = args
        xb = x_pad[tok]
        gu = xb @ w_gu[e] + b_gu[e]
        glu, lin = gu[:, :D_FF], gu[:, D_FF:]
        glu = jnp.minimum(glu, SWIGLU_LIMIT)
        lin = jnp.clip(lin, -SWIGLU_LIMIT, SWIGLU_LIMIT)
        act = glu * jax.nn.sigmoid(SWIGLU_ALPHA * glu) * (lin + 1.0)
        return (act @ w_down[e] + b_down[e]) * wt[:, None]

    y = lax.map(expert_block, (slot_tok.reshape(n_blocks, EXPERT_BLOCK),
                               slot_w.reshape(n_blocks, EXPERT_BLOCK), block_e))
    out = jax.ops.segment_sum(y.reshape(n_slots, D), slot_tok, num_segments=T + 1)[:T]
    return out.reshape(B, S, D)


def setup_inputs(seed: int = 0) -> dict:
    key = jax.random.key(seed)
    ks = jax.random.split(key, 24)
    f32 = jnp.float32
    nrm = lambda k, shape, s: (jax.random.normal(k, shape, f32) * s)
    L, D, E = DEPTH, D_MODEL, N_EXPERTS
    x = jax.random.normal(ks[0], (BATCH, SEQ, D), f32)
    c = jax.random.normal(ks[1], (BATCH, D), f32)
    offset = jax.random.randint(ks[2], (BATCH, 1), 0, 4096, dtype=jnp.int32)
    positions = offset + jnp.arange(SEQ, dtype=jnp.int32)[None, :]
    return {
        "x": x,
        "c": c,
        "positions": positions,
        "ada_w": nrm(ks[3], (L, D, N_MOD * D), 0.5 * D ** -0.5),
        "ada_b": nrm(ks[4], (L, N_MOD * D), 0.02),
        "norm_mix": 1.0 + nrm(ks[5], (L, D), 0.05),
        "norm_ffn": 1.0 + nrm(ks[6], (L, D), 0.05),
        "w_in": nrm(ks[7], (L, D, IN_COLS), D ** -0.5),
        "q_norm": 1.0 + nrm(ks[8], (L, Q_LORA), 0.05),
        "w_uq": nrm(ks[9], (L, Q_LORA, N_HEADS * (QK_NOPE + QK_ROPE)), Q_LORA ** -0.5),
        "kv_norm": 1.0 + nrm(ks[10], (L, KV_LORA), 0.05),
        "w_ukv": nrm(ks[11], (L, KV_LORA, N_HEADS * (QK_NOPE + V_HEAD)), KV_LORA ** -0.5),
        "w_pool": nrm(ks[12], (L, POOL_GROUPS, POOL_GROUP_IN, POOL_GROUP_OUT), POOL_GROUP_IN ** -0.5),
        "pool_scale": 1.0 + nrm(ks[13], (L, POOL_GROUPS, POOL_GROUP_OUT), 0.1),
        "w_out": nrm(ks[14], (L, D, D), D ** -0.5),
        "w_router": nrm(ks[15], (L, D, E), D ** -0.5),
        "b_router": nrm(ks[16], (L, E), 0.01),
        "w_gu": nrm(ks[17], (L, E, D, 2 * D_FF), D ** -0.5),
        "b_gu": nrm(ks[18], (L, E, 2 * D_FF), 0.02),
        "w_down": nrm(ks[19], (L, E, D_FF, D), D_FF ** -0.5),
        "b_down": nrm(ks[20], (L, E, D), 0.02),
        "norm_final": 1.0 + nrm(ks[21], (D,), 0.05),
    }


def reference(x, c, positions, ada_w, ada_b, norm_mix, norm_ffn, w_in, q_norm, w_uq,
              kv_norm, w_ukv, w_pool, pool_scale, w_out, w_router, b_router,
              w_gu, b_gu, w_down, b_down, norm_final):
    cos, sin = rope_tables(positions)
    c_act = jax.nn.silu(c)
    o1 = Q_LORA
    o2 = o1 + KV_LORA
    o3 = o2 + QK_ROPE
    o4 = o3 + POOL_WIDTH
    o5 = o4 + D_MODEL
    for l in range(DEPTH):
        mod = c_act @ ada_w[l] + ada_b[l]
        sh_m, sc_m, g_m, sh_f, sc_f, g_f = [m[:, None, :] for m in jnp.split(mod, N_MOD, axis=-1)]

        h = rmsnorm(x, norm_mix[l]) * (1.0 + sc_m) + sh_m
        z = h @ w_in[l]
        attn = mla_branch(z[..., :o1], z[..., o1:o2], z[..., o2:o3], cos, sin,
                          q_norm[l], w_uq[l], kv_norm[l], w_ukv[l])
        pool = pool_branch(z[..., o3:o4], w_pool[l], pool_scale[l])
        mixed = jax.nn.sigmoid(z[..., o4:o5]) * attn + jax.nn.sigmoid(z[..., o5:]) * pool
        x = x + g_m * (mixed @ w_out[l])

        h = rmsnorm(x, norm_ffn[l]) * (1.0 + sc_f) + sh_f
        x = x + g_f * moe_ffn(h, w_router[l], b_router[l], w_gu[l], b_gu[l], w_down[l], b_down[l])
    return rmsnorm(x, norm_final)
```

```cpp
#include <hip/hip_runtime.h>
#include <cstdio>
#include <cstdint>

#ifndef PROBE_DUP
#define PROBE_DUP -1
#endif
#define REP(k) for (int rep_ = 0; rep_ < ((PROBE_DUP == (k)) ? 2 : 1); ++rep_)
#ifndef MK_N_LAUNCHES
#define MK_N_LAUNCHES 1
#endif

constexpr int BATCH = 2, SEQ = 16384, T = BATCH * SEQ, D = 1024, DEPTH = 2;
constexpr int NH = 8, QKN = 128, QKR = 64, DQK = 192, DV = 128, QL = 384, KVL = 256;
constexpr int PW = 512, NZ = 3264, NZP = 3328;
constexpr int NQ = NH * DQK;
constexpr int NKV = NH * (QKN + DV);
constexpr int NE = 32, TOPK = 4, DFF = 1024;
constexpr float EPS = 1e-6f;
constexpr float QSCALE = 0.07216878364870322f * 1.4426950408889634f * 8.f;
constexpr int ZC_GA = 0, ZC_GB = 1024, ZC_POOL = 2048, ZC_CQ = 2560, ZC_CKV = 2944, ZC_KR = 3200;

constexpr int NWAVES = 8, NTHREADS = 512;
constexpr int NPHASE = 2 + 8 * DEPTH;
constexpr int N_LAUNCHES = MK_N_LAUNCHES;

constexpr size_t MiB = 1u << 20;
constexpr size_t WS_CTL = 0, CTL_ZERO_BYTES = 1 * MiB;
constexpr size_t WS_MOD = 1 * MiB;
constexpr size_t WS_COS = 2 * MiB, WS_SIN = 6 * MiB;
constexpr size_t WS_RSQ = 10 * MiB, WS_RSKV = 11 * MiB;
constexpr size_t WS_WUQ = 12 * MiB;
constexpr size_t WS_WUKV = 15 * MiB;
constexpr size_t WS_WPOOL = 17 * MiB;
constexpr size_t WS_WOUT = 18 * MiB;
constexpr size_t WS_WR = 22 * MiB;
constexpr size_t WS_WIN = 24 * MiB;
constexpr size_t WS_WGU = 40 * MiB;
constexpr size_t WS_WDN = 296 * MiB;
constexpr size_t WS_H8 = 360 * MiB;
constexpr float W8_SCALE = 32.f, W8_INV = 1.f / 32.f;
constexpr size_t WS_SDEST = 424 * MiB, WS_SW = 428 * MiB;
constexpr size_t WS_X1 = 1188 * MiB  , WS_X2 = 560 * MiB;
constexpr size_t WS_H = 1252 * MiB;
constexpr size_t WS_CQ8 = 688 * MiB, WS_CKV8 = 704 * MiB;
constexpr int CQP = 512;
constexpr size_t WS_Z = 752 * MiB;
constexpr size_t WS_Q = 960 * MiB;
constexpr size_t WS_KN = 1056 * MiB, WS_V = 1120 * MiB;
constexpr size_t WS_KR = 1184 * MiB;
constexpr size_t WS_PO = 1188 * MiB;
constexpr size_t WS_MIX = 1252 * MiB;
constexpr int ACT_ROWS = (T * TOPK / 256 + NE) * 256;
constexpr size_t WS_ACT = 752 * MiB;
constexpr size_t WS_Y = 888 * MiB;
constexpr size_t WS_END = 1316 * MiB;

constexpr int CW_TMO = 0;
constexpr int CW_BAR = 4096;
constexpr int CW_ATTQ = 24576;
constexpr int CW_CONV = 28672;
constexpr int CW_CNT = 16384;

constexpr int RING_BYTES = 131072;
constexpr int MISC_OFF = RING_BYTES;
constexpr int TAB_OFF = RING_BYTES + 256;
constexpr int NTR_MAX = T * TOPK / 256 + NE;
constexpr int LDS_BYTES = 147456;

#define GAS __attribute__((address_space(1)))
#define LAS __attribute__((address_space(3)))
typedef unsigned short bf16;
typedef unsigned u32x4 __attribute__((ext_vector_type(4)));
typedef unsigned u32x2 __attribute__((ext_vector_type(2)));
typedef float f32x4 __attribute__((ext_vector_type(4)));
typedef float f32x2 __attribute__((ext_vector_type(2)));
typedef float f32x16 __attribute__((ext_vector_type(16)));
typedef short bf16x8 __attribute__((ext_vector_type(8)));
typedef short s16x4 __attribute__((ext_vector_type(4)));
typedef GAS unsigned gu32;
#define RLX_AGENT __ATOMIC_RELAXED, __HIP_MEMORY_SCOPE_AGENT
#define LDS_WAIT() asm volatile("s_waitcnt lgkmcnt(0)" ::: "memory")
#define VM_WAIT() asm volatile("s_waitcnt vmcnt(0)" ::: "memory")
#define SBAR() __builtin_amdgcn_sched_barrier(0)

__device__ __forceinline__ unsigned cvtpk(float lo, float hi) { unsigned r; asm volatile("v_cvt_pk_bf16_f32 %0, %1, %2" : "=v"(r) : "v"(lo), "v"(hi)); return r; }
__device__ __forceinline__ u32x4 pack8(f32x4 a, f32x4 b) { u32x4 w = {cvtpk(a[0], a[1]), cvtpk(a[2], a[3]), cvtpk(b[0], b[1]), cvtpk(b[2], b[3])}; return w; }
__device__ __forceinline__ float bf2f(unsigned short h) { return __builtin_bit_cast(float, (unsigned)h << 16); }
__device__ __forceinline__ float bflo(unsigned w) { return __builtin_bit_cast(float, w << 16); }
__device__ __forceinline__ float bfhi(unsigned w) { return __builtin_bit_cast(float, w & 0xffff0000u); }
__device__ __forceinline__ unsigned short f2bf(float f) { return (unsigned short)(cvtpk(f, 0.f) & 0xffffu); }
typedef int i32x8 __attribute__((ext_vector_type(8)));
typedef int i32x4 __attribute__((ext_vector_type(4)));
__device__ __forceinline__ unsigned cvt4_fp8(float a, float b, float c, float d) { int w = 0; w = __builtin_amdgcn_cvt_pk_fp8_f32(a, b, w, false); w = __builtin_amdgcn_cvt_pk_fp8_f32(c, d, w, true); return (unsigned)w; }
__device__ __forceinline__ float sigmoid_f(float x) { return __builtin_amdgcn_rcpf(1.f + __builtin_amdgcn_exp2f(-1.4426950408889634f * x)); }
__device__ __forceinline__ float wave_sum(float v) {
#pragma unroll
    for (int o = 1; o < 64; o <<= 1) v += __shfl_xor(v, o);
    return v;
}

#define XB_TMO      128
#define XB_XCNT(j)  (256  + 64 * (j))
#define XB_XSUB(j)  (1280 + 64 * (j))
#define XB_XGEN(j)  (2304 + 64 * (j))
#define XB_TOP      3328
#define XB_TOPGEN   3392
#define XCD_BAR_WORDS 3456
#define XB_SPIN_CAP (1u << 18)

__device__ __forceinline__ unsigned xb_ld(unsigned* p)              { return __hip_atomic_load(p, __ATOMIC_RELAXED, __HIP_MEMORY_SCOPE_AGENT); }
__device__ __forceinline__ unsigned xb_add(unsigned* p, unsigned v) { return __hip_atomic_fetch_add(p, v, __ATOMIC_RELAXED, __HIP_MEMORY_SCOPE_AGENT); }
__device__ __forceinline__ unsigned xb_xcc_id() { return (unsigned)__builtin_amdgcn_s_getreg((3 << 11) | 20) & 0xFu; }
#define XB_SPIN(cond, bar) do { unsigned _sp = 0; while (cond) { __builtin_amdgcn_s_sleep(1); \
    if ((++_sp & 255u) == 0u) { if (xb_ld(&(bar)[XB_TMO])) break; if (_sp > XB_SPIN_CAP) { atomicAdd(&(bar)[XB_TMO], 1u); break; } } } } while (0)

struct XcdBarrier { unsigned* bar; unsigned x; volatile LAS unsigned* st; };

__device__ __forceinline__ XcdBarrier xcd_barrier_post(unsigned* bar, volatile LAS unsigned* st) {
    XcdBarrier b; b.bar = bar; b.x = xb_xcc_id(); b.st = st;
    if (threadIdx.x == 0) (void)xb_add(&bar[XB_XCNT(b.x)], 1u);
    return b;
}
__device__ __forceinline__ void xcd_barrier_complete(unsigned* bar, unsigned x, unsigned& nloc, unsigned& nx) {
    const unsigned G = gridDim.x * gridDim.y * gridDim.z;
    unsigned sum, cnt, mine, sp = 0u;
    for (;;) {
        sum = 0u; cnt = 0u; mine = 0u;
#pragma unroll
        for (unsigned j = 0; j < 16; ++j) { const unsigned c = xb_ld(&bar[XB_XCNT(j)]); sum += c; cnt += (c > 0u) ? 1u : 0u; mine = (j == x) ? c : mine; }
        if (sum == G) break;
        __builtin_amdgcn_s_sleep(1);
        if ((++sp & 255u) == 0u) { if (xb_ld(&bar[XB_TMO])) break; if (sp > XB_SPIN_CAP) { atomicAdd(&bar[XB_TMO], 1u); break; } }
    }
    nloc = mine > 0u ? mine : 1u; nx = cnt > 0u ? cnt : 1u;
}
__device__ __forceinline__ void xcd_barrier(const XcdBarrier& b) {
    asm volatile("s_waitcnt vmcnt(0)" ::: "memory");
    __syncthreads();
    if (threadIdx.x == 0) {
        unsigned* bar = b.bar;
        __builtin_amdgcn_s_waitcnt(0);
        unsigned nloc = b.st[0], nx = b.st[1];
        if (nloc == 0u) { xcd_barrier_complete(bar, b.x, nloc, nx); b.st[0] = nloc; b.st[1] = nx; }
        const unsigned old = xb_add(&bar[XB_XSUB(b.x)], 1u);
        const unsigned gen = old / nloc;
        if (old + 1u == (gen + 1u) * nloc) {
            __builtin_amdgcn_fence(__ATOMIC_RELEASE, "agent");
            asm volatile("s_waitcnt vmcnt(0)" ::: "memory");
            const unsigned og = xb_add(&bar[XB_TOP], 1u);
            const unsigned tg = og / nx;
            if (og + 1u == (tg + 1u) * nx) xb_add(&bar[XB_TOPGEN], 1u);
            else XB_SPIN(xb_ld(&bar[XB_TOPGEN]) == tg, bar);
            __builtin_amdgcn_fence(__ATOMIC_ACQUIRE, "agent");
            xb_add(&bar[XB_XGEN(b.x)], 1u);
            asm volatile("s_waitcnt vmcnt(0)" ::: "memory");
        } else {
            XB_SPIN(xb_ld(&bar[XB_XGEN(b.x)]) == gen, bar);
            __builtin_amdgcn_fence(__ATOMIC_ACQUIRE, "agent");
            asm volatile("s_waitcnt vmcnt(0)" ::: "memory");
        }
    }
    __syncthreads();
}

namespace pg8 {
constexpr int BM = 256, BK = 64, HALF = 128, HTB = HALF * BK * 2, STAGE_BYTES = 8 * HTB, NXCD = 8, WGM = 8;
__host__ __device__ __forceinline__ int lds_byte(int r, int c) { const int st = (r >> 4) * 2 + (c >> 5), rr = r & 15, cc = c & 31, ob = rr * 64 + cc * 2; return st * 1024 + (ob ^ (((ob >> 9) & 1) << 5)); }
__host__ __device__ __forceinline__ void stage_rc(int b, int& R, int& C) { const int st = b / 1024, sb = b % 1024, swz = sb ^ (((sb >> 9) & 1) << 5); R = (st >> 1) * 16 + swz / 64; C = (st & 1) * 32 + (swz % 64) / 2; }
__host__ __device__ __forceinline__ int perm32(int rho) { const int n = rho >> 4, i = rho & 15; return 8 * (i >> 2) + 4 * n + (i & 3); }

struct Unit { int pm, pn, e, r0, cnt; };
struct Gemm { const bf16* A; const bf16* Bt; int lda, K; };

__device__ __forceinline__ void tile_of(int wgid, int nM, int nN, int& pm, int& pn) {
    const int nwg = nM * nN;
    { const int q = nwg / NXCD, r = nwg % NXCD, xcd = wgid % NXCD, off = wgid / NXCD; wgid = (xcd < r ? xcd * (q + 1) : r * (q + 1) + (xcd - r) * q) + off; }
    const int nig = WGM * nN, gid = wgid / nig, fm = gid * WGM, gsz = (nM - fm) < WGM ? (nM - fm) : WGM;
    pm = fm + ((wgid % nig) % gsz); pn = (wgid % nig) / gsz;
}
struct StaticOrder {
    int nM, nN, nwg, G, c;
    __device__ __forceinline__ void init(int nM_, int nN_, int G_, int c_) { nM = nM_; nN = nN_; nwg = nM * nN; G = G_; c = c_; }
    __device__ __forceinline__ bool next(int i, Unit& u) const {
        const long L = (long)i * G + c; if (L >= nwg) return false;
        tile_of((int)L, nM, nN, u.pm, u.pn); u.e = 0; u.r0 = 0; u.cnt = 0; return true;
    }
    __device__ __forceinline__ int arow(const Unit&, int) const { return 0; }
};
struct MoeOrder {
    int nM, nN, nwg, G, c; const LAS int* tinfo; const LAS int* cnt; const int* sdest;
    __device__ __forceinline__ bool next(int i, Unit& u) const {
        const long L = (long)i * G + c; if (L >= nwg) return false;
        int pnl; tile_of((int)L, nM, nN, u.pm, pnl);
        const int ti = tinfo[u.pm]; u.e = ti >> 16; u.r0 = (ti & 0xffff) * 256; u.cnt = cnt[u.e]; u.pn = u.e * nN + pnl; return true;
    }
    __device__ __forceinline__ int arow(const Unit& u, int r) const {
        const int pos = u.r0 + r; int d = 0;
        if (pos < u.cnt) d = sdest[(size_t)u.e * T + pos] >> 2;
        return d;
    }
};

template <class Epi, class Sched, bool GATHER, bool FP8 = false, bool VT = false, int WIDE = 0>
__device__ __forceinline__ void gemm_phase(LAS unsigned char* lds, const Gemm g, const Sched& S, const Epi& E, int tid) {
    const int wid = __builtin_amdgcn_readfirstlane(tid >> 6), lane = tid & 63, wr = wid >> 2, wc = wid & 3, fr = lane & 15, fq = lane >> 4;
    const int K = g.K, nt = K / BK, lda = g.lda;
    unsigned voffB2[2][2];
#pragma unroll
    for (int h = 0; h < 2; ++h)
#pragma unroll
        for (int i = 0; i < 2; ++i) { int R, C; stage_rc(tid * 16 + i * 8192, R, C);
            const int p32 = perm32(R & 31);
            const int Rb = WIDE == 2 ? (64 * (R >> 5) + 16 * (p32 >> 3) + 8 * h + (p32 & 7)) : WIDE == 1 ? (64 * (R >> 5) + 32 * h + p32) : (HALF * h + (R & ~31) + p32); voffB2[h][i] = (unsigned)(Rb * K + C) * 2u; }
    const size_t kstep = (size_t)(BK * 2);
    const size_t hstepB = (size_t)HALF * K * 2;
    const size_t tstepB = 2 * hstepB;
    const unsigned ldsw = (unsigned)wid * 1024u, ldsb = (unsigned)(uintptr_t)lds;
    const int aoff = lds_byte(wr * 64 + fr, fq * 8), boff = lds_byte(wc * 32 + fr, fq * 8);
#define PG8_SA(b, h) (((b) * 2 + (h)) * HTB)
#define PG8_SB(b, h) ((4 + (b) * 2 + (h)) * HTB)
#define PG8_STAGE(bufoff, gbase, voff) do { _Pragma("unroll") for (int _i = 0; _i < 2; ++_i) { unsigned keep_; \
        asm volatile("s_mov_b32 %0, m0\n\ts_mov_b32 m0, %3\n\ts_nop 0\n\tglobal_load_lds_dwordx4 %1, %2\n\ts_mov_b32 m0, %0" : "=&s"(keep_) : "v"((voff)[_i]), "s"((const char*)(gbase)), "s"(ldsb + (unsigned)(bufoff) + ldsw + (unsigned)(_i * 8192)) : "memory"); } } while (0)
#define PG8_LDA(dst, b, h) do { _Pragma("unroll") for (int m = 0; m < 4; ++m) _Pragma("unroll") for (int k = 0; k < 2; ++k) dst[m][k] = *(const LAS bf16x8*)(lds + PG8_SA(b, h) + aoff + m * 2048 + k * 1024); } while (0)
#define PG8_LDB(dst, b, h) do { _Pragma("unroll") for (int n = 0; n < 2; ++n) _Pragma("unroll") for (int k = 0; k < 2; ++k) dst[n][k] = *(const LAS bf16x8*)(lds + PG8_SB(b, h) + boff + n * 2048 + k * 1024); } while (0)
#define PG8_CAT(x0, x1) __builtin_shufflevector(__builtin_bit_cast(i32x4, x0), __builtin_bit_cast(i32x4, x1), 0, 1, 2, 3, 4, 5, 6, 7)
#define PG8_MMA(ai, bj, At, Bt) do { __builtin_amdgcn_s_setprio(1); _Pragma("unroll") for (int m = 0; m < 4; ++m) _Pragma("unroll") for (int n = 0; n < 2; ++n) { \
        if constexpr (FP8 && VT && (bj) == 1) { asm volatile("v_mfma_f32_16x16x128_f8f6f4 %0, %1, %2, %0" : "+v"(acc[ai][bj][m][n]) : "v"(PG8_CAT(At[m][0], At[m][1])), "v"(PG8_CAT(Bt[n][0], Bt[n][1]))); } \
        else if constexpr (FP8) { asm volatile("v_mfma_f32_16x16x128_f8f6f4 %0, %1, %2, %0" : "+v"(acc[ai][bj][m][n]) : "v"(PG8_CAT(Bt[n][0], Bt[n][1])), "v"(PG8_CAT(At[m][0], At[m][1]))); } \
        else if constexpr (VT && (bj) == 1) { _Pragma("unroll") for (int k = 0; k < 2; ++k) acc[ai][bj][m][n] = __builtin_amdgcn_mfma_f32_16x16x32_bf16(At[m][k], Bt[n][k], acc[ai][bj][m][n], 0, 0, 0); } \
        else { _Pragma("unroll") for (int k = 0; k < 2; ++k) acc[ai][bj][m][n] = __builtin_amdgcn_mfma_f32_16x16x32_bf16(Bt[n][k], At[m][k], acc[ai][bj][m][n], 0, 0, 0); } } \
        __builtin_amdgcn_s_setprio(0); } while (0)
#define PG8_WAIT_V(n) asm volatile("s_waitcnt vmcnt(" #n ")" ::: "memory")
#define PG8_WAIT_L(n) asm volatile("s_waitcnt lgkmcnt(" #n ")" ::: "memory")
#define PG8_BAR __builtin_amdgcn_s_barrier()
#define PG8_SCHED __builtin_amdgcn_sched_barrier(0)
#define PG8_SETV(v, u) do { _Pragma("unroll") for (int h_ = 0; h_ < 2; ++h_) _Pragma("unroll") for (int i_ = 0; i_ < 2; ++i_) { int R_, C_; stage_rc(tid * 16 + i_ * 8192, R_, C_); \
        const int r_ = h_ * HALF + R_; const long row_ = GATHER ? (long)S.arow(u, r_) : (long)r_; v[h_][i_] = (unsigned)((row_ * lda + C_) * 2); } } while (0)
    Unit cur, nxt; int ui = 0;
    if (!S.next(0, cur)) return;
    f32x4 acc[2][2][4][2];
#pragma unroll
    for (int a = 0; a < 2; ++a)
#pragma unroll
        for (int b = 0; b < 2; ++b)
#pragma unroll
            for (int m = 0; m < 4; ++m)
#pragma unroll
                for (int n = 0; n < 2; ++n) acc[a][b][m][n] = (f32x4){0.f, 0.f, 0.f, 0.f};
    bf16x8 At[4][2], B0[2][2], B1[2][2];
    unsigned vA[2][2], vN[2][2];
    PG8_SETV(vA, cur);
    const size_t tstepA = (size_t)BM * lda * 2;
    const char* cA = (const char*)g.A + (GATHER ? (size_t)0 : (size_t)cur.pm * tstepA); const char* cB = (const char*)g.Bt + (size_t)cur.pn * tstepB;
    PG8_STAGE(PG8_SB(0, 0), cB, voffB2[0]); PG8_STAGE(PG8_SB(0, 1), cB, voffB2[1]); PG8_STAGE(PG8_SA(0, 0), cA, vA[0]); PG8_STAGE(PG8_SA(0, 1), cA, vA[1]);
    if (wr == 1) PG8_BAR;
    PG8_WAIT_V(2); PG8_BAR;
    PG8_STAGE(PG8_SB(1, 0), cB + kstep, voffB2[0]); PG8_STAGE(PG8_SA(1, 0), cA + kstep, vA[0]); PG8_STAGE(PG8_SB(1, 1), cB + kstep, voffB2[1]);
    PG8_WAIT_V(6); PG8_BAR;
    for (;;) {
        const bool has_next = S.next(ui + 1, nxt);
        const char* nA = has_next ? (const char*)g.A + (GATHER ? (size_t)0 : (size_t)nxt.pm * tstepA) : cA; const char* nB = has_next ? (const char*)g.Bt + (size_t)nxt.pn * tstepB : cB;
        if (GATHER) { if (has_next) { PG8_SETV(vN, nxt); } else {
#pragma unroll
            for (int h_ = 0; h_ < 2; ++h_)
#pragma unroll
                for (int i_ = 0; i_ < 2; ++i_) vN[h_][i_] = vA[h_][i_]; } }
#pragma unroll 1
        for (int t = 0; t < nt; t += 2) {
            const bool last = (t == nt - 2);
            const char* a1 = cA + (size_t)(t + 1) * kstep;
            const char* a2 = last ? nA : cA + (size_t)(t + 2) * kstep; const char* b2 = last ? nB : cB + (size_t)(t + 2) * kstep;
            const char* a3 = a2 + kstep; const char* b3 = b2 + kstep;
            unsigned v2[2][2];
#pragma unroll
            for (int h_ = 0; h_ < 2; ++h_)
#pragma unroll
                for (int i_ = 0; i_ < 2; ++i_) v2[h_][i_] = GATHER ? (last ? vN[h_][i_] : vA[h_][i_]) : vA[h_][i_];
            PG8_LDB(B0, 0, 0); PG8_LDB(B1, 0, 1); PG8_SCHED; PG8_LDA(At, 0, 0); PG8_STAGE(PG8_SA(1, 1), a1, vA[1]);
            PG8_WAIT_V(8); PG8_WAIT_L(0); PG8_BAR; PG8_MMA(0, 0, At, B0); PG8_MMA(0, 1, At, B1); PG8_BAR; PG8_SCHED;
            PG8_LDA(At, 0, 1); PG8_STAGE(PG8_SB(0, 0), b2, voffB2[0]); PG8_STAGE(PG8_SB(0, 1), b2, voffB2[1]); PG8_STAGE(PG8_SA(0, 0), a2, v2[0]);
            PG8_WAIT_V(8); PG8_WAIT_L(0); PG8_BAR; PG8_MMA(1, 0, At, B0); PG8_MMA(1, 1, At, B1); PG8_BAR; PG8_SCHED;
            PG8_LDB(B0, 1, 0); PG8_LDB(B1, 1, 1); PG8_SCHED; PG8_LDA(At, 1, 0); PG8_STAGE(PG8_SA(0, 1), a2, v2[1]);
            PG8_WAIT_V(8); PG8_WAIT_L(0); PG8_BAR; PG8_MMA(0, 0, At, B0); PG8_MMA(0, 1, At, B1); PG8_BAR; PG8_SCHED;
            PG8_LDA(At, 1, 1); PG8_STAGE(PG8_SB(1, 0), b3, voffB2[0]); PG8_STAGE(PG8_SB(1, 1), b3, voffB2[1]); PG8_STAGE(PG8_SA(1, 0), a3, v2[0]);
            PG8_WAIT_V(8); PG8_WAIT_L(0); PG8_BAR; PG8_MMA(1, 0, At, B0); PG8_MMA(1, 1, At, B1); PG8_BAR; PG8_SCHED;
        }
        if (wr == 0) PG8_BAR;
        if constexpr (FP8) asm volatile("s_nop 15\n\ts_nop 7" ::: "memory");
        E(acc, cur, wr, wc, fr, fq);
        if (!has_next) break;
#pragma unroll
        for (int a = 0; a < 2; ++a)
#pragma unroll
            for (int b = 0; b < 2; ++b)
#pragma unroll
                for (int m = 0; m < 4; ++m)
#pragma unroll
                    for (int n = 0; n < 2; ++n) acc[a][b][m][n] = (f32x4){0.f, 0.f, 0.f, 0.f};
        cur = nxt; cA = nA; cB = nB; ++ui;
        if (GATHER) {
#pragma unroll
            for (int h_ = 0; h_ < 2; ++h_)
#pragma unroll
                for (int i_ = 0; i_ < 2; ++i_) vA[h_][i_] = vN[h_][i_]; }
        if (wr == 1) PG8_BAR;
    }
    PG8_WAIT_V(0);
    PG8_BAR;
#undef PG8_SA
#undef PG8_SB
#undef PG8_STAGE
#undef PG8_LDA
#undef PG8_LDB
#undef PG8_MMA
#undef PG8_CAT
#undef PG8_WAIT_V
#undef PG8_WAIT_L
#undef PG8_BAR
#undef PG8_SCHED
#undef PG8_SETV
}

typedef const f32x4 (&AccRef)[2][2][4][2];

__device__ __forceinline__ float quad_sum(float s) { s += __shfl_xor(s, 16); s += __shfl_xor(s, 32); return s; }

__device__ __forceinline__ u32x4 ror8x4(u32x4 v) {
    u32x4 r;
#pragma unroll
    for (int i = 0; i < 4; ++i) r[i] = (unsigned)__builtin_amdgcn_update_dpp(0, (int)v[i], 0x128, 0xf, 0xf, false);
    return r;
}
struct EpiZ {
    bf16* Z; unsigned char* KR; float* RSQ; float* RSKV; const float* COS; const float* SIN; unsigned char* CQ8; unsigned char* CKV8;
    __device__ __forceinline__ void operator()(AccRef acc, const Unit& u, int wr, int wc, int fr, int fq) const {
        const int pn = u.pn; const bool lo8 = fr < 8;
#pragma unroll
        for (int ai = 0; ai < 2; ++ai)
#pragma unroll
            for (int m = 0; m < 4; ++m) {
                const int row = u.pm * BM + ai * HALF + wr * 64 + m * 16 + fr;
                f32x4 v[2][2]; float ss = 0.f;
                if (pn < 8) {
#pragma unroll
                    for (int bj = 0; bj < 2; ++bj)
#pragma unroll
                        for (int hh = 0; hh < 2; ++hh)
#pragma unroll
                            for (int i = 0; i < 4; ++i) v[bj][hh][i] = __builtin_amdgcn_rcpf(1.f + __builtin_amdgcn_exp2f(acc[ai][bj][m][hh][i] * (-1.4426950408889634f * W8_INV)));
                    const u32x4 w0 = pack8(v[0][0], v[0][1]), w1 = pack8(v[1][0], v[1][1]);
                    const u32x4 rcv = ror8x4(lo8 ? w1 : w0);
                    bf16* zb = Z + (size_t)(lo8 ? row : row - 8) * NZP + pn * BM + wc * 64 + (lo8 ? fq : 4 + fq) * 8;
                    __builtin_nontemporal_store(lo8 ? w0 : rcv, (u32x4*)zb);
                    __builtin_nontemporal_store(lo8 ? rcv : w1, (u32x4*)(zb + (size_t)8 * NZP));
                    continue;
                }
#pragma unroll
                for (int bj = 0; bj < 2; ++bj) {
                    v[bj][0] = acc[ai][bj][m][0] * W8_INV; v[bj][1] = acc[ai][bj][m][1] * W8_INV;
                    ss += (v[bj][0][0] * v[bj][0][0] + v[bj][0][1] * v[bj][0][1]) + (v[bj][0][2] * v[bj][0][2] + v[bj][0][3] * v[bj][0][3])
                        + (v[bj][1][0] * v[bj][1][0] + v[bj][1][1] * v[bj][1][1]) + (v[bj][1][2] * v[bj][1][2] + v[bj][1][3] * v[bj][1][3]);
                }
                if (pn == 12 && wc >= 2) {
                    if (wc == 2) {
#pragma unroll
                        for (int bj = 0; bj < 2; ++bj) { const int gq = 4 * bj + fq;
                            const f32x4 cs = *(const f32x4*)(COS + (size_t)row * 32 + 4 * gq), sn = *(const f32x4*)(SIN + (size_t)row * 32 + 4 * gq);
                            const f32x4 o1 = v[bj][0] * cs - v[bj][1] * sn, o2 = v[bj][1] * cs + v[bj][0] * sn;
                            u32x2 o8 = {cvt4_fp8(o1[0], o1[1], o1[2], o1[3]), cvt4_fp8(o2[0], o2[1], o2[2], o2[3])};
                            *(u32x2*)(KR + (size_t)row * 64 + 8 * gq) = o8; }
                    }
                } else if (pn >= 10) {
                    const bool isq = pn == 10 || (pn == 11 && wc < 2);
                    const int cb = (pn == 10) ? 64 * wc : (pn == 11) ? (wc < 2 ? 256 + 64 * wc : 64 * (wc - 2)) : 128 + 64 * wc;
                    unsigned char* dp = (isq ? CQ8 + (size_t)row * CQP : CKV8 + (size_t)row * KVL) + cb + 8 * fq;
#pragma unroll
                    for (int bj = 0; bj < 2; ++bj) { u32x2 o8 = {cvt4_fp8(v[bj][0][0], v[bj][0][1], v[bj][0][2], v[bj][0][3]), cvt4_fp8(v[bj][1][0], v[bj][1][1], v[bj][1][2], v[bj][1][3])};
                        *(u32x2*)(dp + 32 * bj) = o8;
                        if (pn == 11 && wc < 2) *(u32x2*)(dp + 128 + 32 * bj) = (u32x2){0u, 0u}; }
                } else {
                    const u32x4 w0 = pack8(v[0][0], v[0][1]), w1 = pack8(v[1][0], v[1][1]);
                    const u32x4 rcv = ror8x4(lo8 ? w1 : w0);
                    bf16* zb = Z + (size_t)(lo8 ? row : row - 8) * NZP + pn * BM + wc * 64 + (lo8 ? fq : 4 + fq) * 8;
                    __builtin_nontemporal_store(lo8 ? w0 : rcv, (u32x4*)zb);
                    __builtin_nontemporal_store(lo8 ? rcv : w1, (u32x4*)(zb + (size_t)8 * NZP));
                }
                if (pn >= 10) {
                    const float s = quad_sum(ss);
                    if (fq == 0) {
                        if (pn == 10) RSQ[(size_t)row * 8 + wc] = s;
                        else if (pn == 11) { RSQ[(size_t)row * 8 + 4 + wc] = wc < 2 ? s : 0.f; if (wc >= 2) RSKV[(size_t)row * 8 + wc - 2] = s; }
                        else { if (wc < 2) RSKV[(size_t)row * 8 + 2 + wc] = s; RSKV[(size_t)row * 8 + 4 + wc] = 0.f; }
                    }
                }
            }
    }
};
struct EpiQ {
    unsigned char* Q; const float* RSQ; const float* COS; const float* SIN;
    __device__ __forceinline__ void operator()(AccRef acc, const Unit& u, int wr, int wc, int fr, int fq) const {
#pragma unroll
        for (int ai = 0; ai < 2; ++ai)
#pragma unroll
            for (int m = 0; m < 4; ++m) {
                const int row = u.pm * BM + ai * HALF + wr * 64 + m * 16 + fr;
                const f32x4 r0 = *(const f32x4*)(RSQ + (size_t)row * 8), r1 = *(const f32x4*)(RSQ + (size_t)row * 8 + 4);
                const float ssq = ((r0[0] + r0[1]) + (r0[2] + r0[3])) + ((r1[0] + r1[1]) + (r1[2] + r1[3]));
                const float inv = __builtin_amdgcn_rsqf(ssq * (1.f / QL) + EPS) * W8_INV;
#pragma unroll
                for (int bj = 0; bj < 2; ++bj) {
                    const int c0 = u.pn * BM + bj * HALF + wc * 32 + 8 * fq;
                    const int head = c0 / DQK, within = c0 - head * DQK;
                    f32x4 v0 = acc[ai][bj][m][0] * inv, v1 = acc[ai][bj][m][1] * inv;
                    if (within >= QKN) {
                        const int gq = (within - QKN) >> 3;
                        const f32x4 cs = *(const f32x4*)(COS + (size_t)row * 32 + 4 * gq), sn = *(const f32x4*)(SIN + (size_t)row * 32 + 4 * gq);
                        const f32x4 o1 = v0 * cs - v1 * sn, o2 = v1 * cs + v0 * sn; v0 = o1; v1 = o2;
                    }
                    { u32x2 o8 = {cvt4_fp8(v0[0], v0[1], v0[2], v0[3]), cvt4_fp8(v1[0], v1[1], v1[2], v1[3])}; *(u32x2*)(Q + (size_t)row * NQ + c0) = o8; }
                }
            }
    }
};
struct EpiKV {
    unsigned char* KN; unsigned char* VT; const float* RSKV;
    __device__ __forceinline__ void operator()(AccRef acc, const Unit& u, int wr, int wc, int fr, int fq) const {
        const int lane = fq * 16 + fr;
#pragma unroll
        for (int ai = 0; ai < 2; ++ai) {
            f32x4 iv[4];
#pragma unroll
            for (int m = 0; m < 4; ++m) {
                const int row = u.pm * BM + ai * HALF + wr * 64 + m * 16 + fr;
                const f32x4 r0 = *(const f32x4*)(RSKV + (size_t)row * 8), r1 = *(const f32x4*)(RSKV + (size_t)row * 8 + 4);
                const float ssq = ((r0[0] + r0[1]) + (r0[2] + r0[3])) + ((r1[0] + r1[1]) + (r1[2] + r1[3]));
                const float inv = __builtin_amdgcn_rsqf(ssq * (1.f / KVL) + EPS) * W8_INV;
                const size_t o = (size_t)row * 1024 + u.pn * 128 + wc * 32 + 8 * fq;
                { const f32x4 k0 = acc[ai][0][m][0] * inv, k1 = acc[ai][0][m][1] * inv; u32x2 o8 = {cvt4_fp8(k0[0], k0[1], k0[2], k0[3]), cvt4_fp8(k1[0], k1[1], k1[2], k1[3])}; *(u32x2*)(KN + o) = o8; }
#pragma unroll
                for (int r = 0; r < 4; ++r) iv[m][r] = __shfl(inv, (lane & 48) | (4 * fq + r));
            }
            const int tokt = u.pm * 4 + ai * 2 + wr;
            const int bb = tokt >> 8, jt = tokt & 255, pos16 = 32 * (fq & 1) + 16 * (fq >> 1);
#pragma unroll
            for (int n = 0; n < 2; ++n) {
                const int dv = wc * 32 + 8 * (fr >> 2) + 4 * n + (fr & 3);
                unsigned w[4];
#pragma unroll
                for (int m = 0; m < 4; ++m) { const f32x4 v = acc[ai][1][m][n] * iv[m]; w[m] = cvt4_fp8(v[0], v[1], v[2], v[3]); }
                auto ra = __builtin_amdgcn_permlane32_swap(w[0], w[2], false, false); auto rb = __builtin_amdgcn_permlane32_swap(w[1], w[3], false, false);
                u32x4 o16 = {ra[0], ra[1], rb[0], rb[1]};
                *(u32x4*)(VT + ((((size_t)bb * NH + u.pn) * 256 + jt) * 128 + dv) * 64 + pos16) = o16;
            }
        }
    }
};
struct EpiOut {
    bf16* DX; const float* gm;
    __device__ __forceinline__ void operator()(AccRef acc, const Unit& u, int wr, int wc, int fr, int fq) const {
        const bool lo8 = fr < 8;
#pragma unroll
        for (int ai = 0; ai < 2; ++ai)
#pragma unroll
            for (int m = 0; m < 4; ++m) {
                const int row = u.pm * BM + ai * HALF + wr * 64 + m * 16 + fr;
                const int b = row >= SEQ ? 1 : 0;
                u32x4 w[2];
#pragma unroll
                for (int bj = 0; bj < 2; ++bj) {
                    const float* gp = gm + b * 6 * D + u.pn * BM + wc * 64 + bj * 32 + 8 * fq;
                    const f32x4 g0 = *(const f32x4*)gp, g1 = *(const f32x4*)(gp + 4);
                    w[bj] = pack8(g0 * acc[ai][bj][m][0], g1 * acc[ai][bj][m][1]);
                }
                const u32x4 rcv = ror8x4(lo8 ? w[1] : w[0]);
                bf16* zb = DX + (size_t)(lo8 ? row : row - 8) * D + u.pn * BM + wc * 64 + (lo8 ? fq : 4 + fq) * 8;
                __builtin_nontemporal_store(lo8 ? w[0] : rcv, (u32x4*)zb);
                __builtin_nontemporal_store(lo8 ? rcv : w[1], (u32x4*)(zb + (size_t)8 * D));
            }
    }
};
struct EpiGU {
    unsigned char* ACT; const float* bgu;
    __device__ __forceinline__ void operator()(AccRef acc, const Unit& u, int wr, int wc, int fr, int fq) const {
        const int pnl = u.pn & 7, j0 = pnl * 128 + wc * 32 + 8 * fq;
        const float* bp = bgu + (size_t)u.e * 2 * DFF + j0;
        constexpr float CG = -1.702f * 1.4426950408889634f, SG = CG * W8_INV, SL = W8_INV / CG, GMIN = 7.f * CG, LLO = 8.f / CG, LHI = -6.f / CG;
        const f32x4 bg0 = *(const f32x4*)bp * CG, bg1 = *(const f32x4*)(bp + 4) * CG, bl0 = (*(const f32x4*)(bp + DFF) + 1.f) * (1.f / CG), bl1 = (*(const f32x4*)(bp + DFF + 4) + 1.f) * (1.f / CG);
#pragma unroll
        for (int ai = 0; ai < 2; ++ai)
#pragma unroll
            for (int m = 0; m < 4; ++m) {
                const int row = u.pm * BM + ai * HALF + wr * 64 + m * 16 + fr;
                f32x4 a0, a1;
#pragma unroll
                for (int i = 0; i < 4; ++i) {
                    float gp = fmaxf(__builtin_fmaf(acc[ai][0][m][0][i], SG, bg0[i]), GMIN), lp = __builtin_amdgcn_fmed3f(__builtin_fmaf(acc[ai][1][m][0][i], SL, bl0[i]), LLO, LHI);
                    a0[i] = gp * __builtin_amdgcn_rcpf(1.f + __builtin_amdgcn_exp2f(gp)) * lp;
                    gp = fmaxf(__builtin_fmaf(acc[ai][0][m][1][i], SG, bg1[i]), GMIN); lp = __builtin_amdgcn_fmed3f(__builtin_fmaf(acc[ai][1][m][1][i], SL, bl1[i]), LLO, LHI);
                    a1[i] = gp * __builtin_amdgcn_rcpf(1.f + __builtin_amdgcn_exp2f(gp)) * lp;
                }
                u32x2 o = {cvt4_fp8(a0[0], a0[1], a0[2], a0[3]), cvt4_fp8(a1[0], a1[1], a1[2], a1[3])};
                __builtin_nontemporal_store(o, (u32x2*)(ACT + (size_t)row * DFF + j0));
            }
    }
};
struct EpiDown {
    unsigned char* Y; const float* bdn; const int* sdest; const float* sw;
    __device__ __forceinline__ void operator()(AccRef acc, const Unit& u, int wr, int wc, int fr, int fq) const {
        const int pnl = u.pn & 3, c0 = pnl * BM + wc * 64 + 16 * fq;
        const float* bp = bdn + (size_t)u.e * D + c0;
        const f32x4 b00 = *(const f32x4*)bp, b01 = *(const f32x4*)(bp + 4), b10 = *(const f32x4*)(bp + 8), b11 = *(const f32x4*)(bp + 12);
        int dst8[8]; float wt8[8];
#pragma unroll
        for (int q = 0; q < 8; ++q) { const int pos = u.r0 + (q >> 2) * HALF + wr * 64 + (q & 3) * 16 + fr; const int pc = pos < u.cnt ? pos : u.cnt - 1;
            dst8[q] = sdest[(size_t)u.e * T + pc]; wt8[q] = sw[(size_t)u.e * T + pc]; }
#pragma unroll
        for (int ai = 0; ai < 2; ++ai)
#pragma unroll
            for (int m = 0; m < 4; ++m) {
                const int pos = u.r0 + ai * HALF + wr * 64 + m * 16 + fr;
                if (pos < u.cnt) {
                    const int dest = dst8[ai * 4 + m]; const float w = wt8[ai * 4 + m];
                    const f32x4 y00 = (acc[ai][0][m][0] * W8_INV + b00) * w, y01 = (acc[ai][0][m][1] * W8_INV + b01) * w;
                    const f32x4 y10 = (acc[ai][1][m][0] * W8_INV + b10) * w, y11 = (acc[ai][1][m][1] * W8_INV + b11) * w;
                    const u32x4 o = {cvt4_fp8(y00[0], y00[1], y00[2], y00[3]), cvt4_fp8(y01[0], y01[1], y01[2], y01[3]), cvt4_fp8(y10[0], y10[1], y10[2], y10[3]), cvt4_fp8(y11[0], y11[1], y11[2], y11[3])};
                    __builtin_nontemporal_store(o, (u32x4*)(Y + (size_t)dest * D + c0));
                }
            }
    }
};
}

namespace att {
constexpr int KSLOT = 12288, VSLOT = 8192, NSLOT = 3;
constexpr int STG_PITCH = 272, STG_WAVE = 32 * STG_PITCH;
constexpr int LDS_K = 0, LDS_V = NSLOT * KSLOT, LDS_RING_END = LDS_V + NSLOT * VSLOT, LDS_WS = LDS_RING_END > NWAVES * STG_WAVE ? LDS_RING_END : NWAVES * STG_WAVE, LDS_END = LDS_WS + NWAVES * 64 * 4;
static_assert(LDS_END <= RING_BYTES && NWAVES * STG_WAVE <= LDS_WS, "attention LDS map");
constexpr float THR2 = 8.f;

__device__ __forceinline__ int crow(int r, int hi) { return (r & 3) + 8 * (r >> 2) + 4 * hi; }
__device__ __forceinline__ int v_rd_base(int lane) { return ((lane & 3) << 3) | (((lane >> 2) & 3) << 6) | (((lane >> 4) & 1) << 5) | (((lane >> 5) & 1) << 8); }
constexpr int v_rd_off(int d0, int ks, int half) { return d0 * 512 + ks * 4096 + half * 2048; }
__device__ __forceinline__ void glds16(const void* gsrc, unsigned lds_dst) { unsigned keep;
    asm volatile("s_mov_b32 %0, m0\n\ts_mov_b32 m0, %2\n\ts_nop 0\n\tglobal_load_lds_dwordx4 %1, off\n\ts_mov_b32 m0, %0" : "=&s"(keep) : "v"(gsrc), "s"(lds_dst) : "memory"); }

__device__ __forceinline__ void mask_tile(f32x16& p0, f32x16& p1, int dq) {
    const float NEG = -__builtin_inff();
#pragma unroll
    for (int r = 0; r < 16; ++r) {
        const int c = (r & 3) + 8 * (r >> 2);
        if (dq - c < 0) p0[r] = NEG;
        if (dq - c - 32 < 0) p1[r] = NEG;
    }
}
__device__ __forceinline__ void softmax_ref(f32x16& p0, f32x16& p1, bool first, f32x16& negm, float& alpha) {
    float a = fmaxf(fmaxf(p0[0], p0[1]), p1[0]), b = fmaxf(fmaxf(p0[2], p0[3]), p1[1]);
#pragma unroll
    for (int r = 4; r < 16; r += 4) { a = fmaxf(fmaxf(a, p0[r]), p0[r + 1]); b = fmaxf(fmaxf(b, p0[r + 2]), p0[r + 3]); }
#pragma unroll
    for (int r = 2; r < 16; r += 2) { a = fmaxf(a, p1[r]); b = fmaxf(b, p1[r + 1]); }
    float pmax = fmaxf(a, b);
    { auto rr = __builtin_amdgcn_permlane32_swap(__float_as_uint(pmax), __float_as_uint(pmax), false, false);
      pmax = fmaxf(__uint_as_float(rr[0]), __uint_as_float(rr[1])); }
    alpha = 1.f;
    if (__builtin_expect(first || __any(pmax > THR2), 0)) {
        const float d = first ? pmax : fmaxf(pmax, 0.f);
        alpha = __builtin_amdgcn_exp2f(-d);
#pragma unroll
        for (int r = 0; r < 16; ++r) { p0[r] -= d; p1[r] -= d; negm[r] -= d; }
    }
}
__device__ __forceinline__ void exp16(f32x16& p) {
#pragma unroll
    for (int r = 0; r < 16; ++r) p[r] = __builtin_amdgcn_exp2f(p[r]);
}
__device__ __forceinline__ void pack_p(const f32x16& p0, const f32x16& p1, i32x8& pa) {
#pragma unroll
    for (int i = 0; i < 4; ++i) { pa[i] = (int)cvt4_fp8(p0[4 * i], p0[4 * i + 1], p0[4 * i + 2], p0[4 * i + 3]); pa[4 + i] = (int)cvt4_fp8(p1[4 * i], p1[4 * i + 1], p1[4 * i + 2], p1[4 * i + 3]); }
}
__device__ __forceinline__ void qkt8(f32x16& p0, f32x16& p1, const LAS char* Kslot, int r32, int hi, const i32x8* q8, const f32x16& negm) {
    p0 = negm; p1 = negm;
    const int key = (r32 >> 2) & 3;
    const LAS char* ka = Kslot + r32 * 64 + (((2 * hi) ^ key) << 4);
    const LAS char* kb = Kslot + r32 * 64 + (((2 * hi + 1) ^ key) << 4);
#pragma unroll
    for (int j = 0; j < 3; ++j) {
        const i32x4 a0 = *reinterpret_cast<const LAS i32x4*>(ka + j * 4096), a1 = *reinterpret_cast<const LAS i32x4*>(kb + j * 4096);
        const i32x4 b0 = *reinterpret_cast<const LAS i32x4*>(ka + j * 4096 + 2048), b1 = *reinterpret_cast<const LAS i32x4*>(kb + j * 4096 + 2048);
        p0 = __builtin_amdgcn_mfma_scale_f32_32x32x64_f8f6f4(__builtin_shufflevector(a0, a1, 0, 1, 2, 3, 4, 5, 6, 7), q8[j], p0, 0, 0, 0, 0x7f7f7f7f, 0, 0x7c7c7c7c);
        p1 = __builtin_amdgcn_mfma_scale_f32_32x32x64_f8f6f4(__builtin_shufflevector(b0, b1, 0, 1, 2, 3, 4, 5, 6, 7), q8[j], p1, 0, 0, 0, 0x7f7f7f7f, 0, 0x7c7c7c7c);
    }
}
__device__ __forceinline__ void pv8(f32x16* o, const LAS char* Vslot, int r32, int hi, const i32x8& pa) {
    const int key = (r32 >> 2) & 3;
    const LAS char* va = Vslot + r32 * 64 + (((2 * hi) ^ key) << 4);
    const LAS char* vb = Vslot + r32 * 64 + (((2 * hi + 1) ^ key) << 4);
#pragma unroll
    for (int d0 = 0; d0 < 4; ++d0) {
        const i32x4 b0 = *reinterpret_cast<const LAS i32x4*>(va + d0 * 2048), b1 = *reinterpret_cast<const LAS i32x4*>(vb + d0 * 2048);
        o[d0] = __builtin_amdgcn_mfma_scale_f32_32x32x64_f8f6f4(pa, __builtin_shufflevector(b0, b1, 0, 1, 2, 3, 4, 5, 6, 7), o[d0], 0, 0, 0, 0x7f7f7f7f, 0, 0x7f7f7f7f);
    }
}

struct Tensors { const unsigned char* Q; const unsigned char* KN; const unsigned char* KR; const unsigned char* VT; const bf16* Z; const bf16* PO; bf16* MIX; };

__device__ __forceinline__ void attn_unit(int b, int h, int qb, const Tensors& Tn, LAS char* shm, int tid) {
    const int lane = tid & 63, r32 = lane & 31, hi = lane >> 5; const int wid = __builtin_amdgcn_readfirstlane(tid >> 6);
    const int tok0 = b * SEQ, q0 = qb * 256, NT = 4 * (qb + 1);
    const unsigned lds0 = (unsigned)(uintptr_t)shm;
    LAS float* wsf = (LAS float*)(shm + LDS_WS) + wid * 64;
    const int krow = (wid & 3) * 16 + (lane >> 2), kc = (lane & 3) ^ ((krow >> 2) & 3);
    const unsigned char* ksA = (wid < 4) ? Tn.KN + ((size_t)(tok0 + krow) * NH + h) * 128 + kc * 16
                                         : Tn.KN + ((size_t)(tok0 + krow) * NH + h) * 128 + 64 + kc * 16;
    const unsigned char* ksB = Tn.KR + (size_t)(tok0 + krow) * 64 + kc * 16;
    const int vrow = wid * 16 + (lane >> 2), vc = (lane & 3) ^ ((vrow >> 2) & 3);
    const unsigned char* vsA = Tn.VT + (((size_t)(b * NH + h) * 256) * 128 + vrow) * 64 + vc * 16;
    const bool kx = wid < 4;
#define DMA_TILE(t, slot) do { const size_t ko_ = (size_t)(t) * 64 * (NH * 128), ro_ = (size_t)(t) * 64 * 64, vo_ = (size_t)(t) * 8192; \
        const unsigned kd_ = (unsigned)__builtin_amdgcn_readfirstlane(lds0 + LDS_K + (slot) * KSLOT + wid * 1024), vd_ = (unsigned)__builtin_amdgcn_readfirstlane(lds0 + LDS_V + (slot) * VSLOT + wid * 1024); \
        glds16(ksA + ko_, kd_); if (kx) glds16(ksB + ro_, kd_ + 8192); glds16(vsA + vo_, vd_); } while (0)
#define WAIT_TILE(more_) do { if (more_) { if (kx) asm volatile("s_waitcnt vmcnt(3)" ::: "memory"); else asm volatile("s_waitcnt vmcnt(2)" ::: "memory"); } else asm volatile("s_waitcnt vmcnt(0)" ::: "memory"); } while (0)
    i32x8 q8[3];
    { const unsigned char* qp = Tn.Q + ((size_t)(tok0 + q0 + wid * 32 + r32) * NH + h) * DQK + hi * 32;
#pragma unroll
      for (int j = 0; j < 3; ++j) { const i32x4 x0 = *reinterpret_cast<const i32x4*>(qp + j * 64), x1 = *reinterpret_cast<const i32x4*>(qp + j * 64 + 16); q8[j] = __builtin_shufflevector(x0, x1, 0, 1, 2, 3, 4, 5, 6, 7); } }
#pragma unroll
    for (int j = 0; j < 3; ++j) asm volatile("" : "+v"(q8[j]));
    asm volatile("" ::: "memory");
    DMA_TILE(0, 0); DMA_TILE(1, 1);
    f32x16 o[4], negm = f32x16{}; float l_reg = 0.f;
#pragma unroll
    for (int d = 0; d < 4; ++d) o[d] = f32x16{};
    const int qlo = q0 + wid * 32, qm = qlo + r32 - 4 * hi;
    WAIT_TILE(true); asm volatile("s_barrier" ::: "memory");
    const bool g1 = wid >= 4;
    if (g1) asm volatile("s_barrier" ::: "memory");
    int slot = 0;
    for (int t = 0; t < NT; ++t) {
        const bool more = t + 2 < NT; const int s2 = slot >= 1 ? slot - 1 : 2;
        const int kb = t * 64; const bool act = kb <= qlo + 31;
        f32x16 p0, p1; float alpha = 1.f;
        if (g1 && more) DMA_TILE(t + 2, s2);
        if (act) {
            qkt8(p0, p1, shm + LDS_K + slot * KSLOT, r32, hi, q8, negm);
            if (kb + 63 > qlo) mask_tile(p0, p1, qm - kb);
            softmax_ref(p0, p1, t == 0, negm, alpha);
            exp16(p0);
        }
        if (g1) WAIT_TILE(more);
        asm volatile("s_waitcnt lgkmcnt(0)\n\ts_barrier" ::: "memory");
        if (!g1 && more) DMA_TILE(t + 2, s2);
        if (act) {
            i32x8 pa;
            exp16(p1); pack_p(p0, p1, pa);
            { float s0 = p0[0] + p0[1], s1 = p0[2] + p0[3], s2 = p1[0] + p1[1], s3 = p1[2] + p1[3];
#pragma unroll
              for (int r = 4; r < 16; r += 4) { s0 += p0[r] + p0[r + 1]; s1 += p0[r + 2] + p0[r + 3]; s2 += p1[r] + p1[r + 1]; s3 += p1[r + 2] + p1[r + 3]; }
              float ps = (s0 + s1) + (s2 + s3); auto rr = __builtin_amdgcn_permlane32_swap(__float_as_uint(ps), __float_as_uint(ps), false, false);
              l_reg = l_reg * alpha + (__uint_as_float(rr[0]) + __uint_as_float(rr[1])); }
            if (__any(alpha < 1.f)) { if (hi == 0) wsf[r32] = alpha; LDS_WAIT();
#pragma unroll
                for (int d_ = 0; d_ < 4; ++d_)
#pragma unroll
                    for (int r = 0; r < 16; ++r) o[d_][r] *= wsf[crow(r, hi)]; }
            pv8(o, shm + LDS_V + slot * VSLOT, r32, hi, pa);
        }
        if (!g1) WAIT_TILE(more);
        asm volatile("s_waitcnt lgkmcnt(0)\n\ts_barrier" ::: "memory");
        slot = slot == 2 ? 0 : slot + 1;
    }
    if (!g1) asm volatile("s_barrier" ::: "memory");
    asm volatile("s_waitcnt vmcnt(0)" ::: "memory");
#undef DMA_TILE
#undef WAIT_TILE
    if (hi == 0) wsf[32 + r32] = l_reg;
    LDS_WAIT();
    float rli[16];
#pragma unroll
    for (int r = 0; r < 16; ++r) rli[r] = __builtin_amdgcn_rcpf(wsf[32 + crow(r, hi)]);
    LAS char* stg = shm + wid * STG_WAVE;
#pragma unroll
    for (int hc = 0; hc < 2; ++hc) {
#pragma unroll
        for (int dd = 0; dd < 2; ++dd)
#pragma unroll
            for (int r = 0; r < 16; ++r) *(LAS float*)(stg + crow(r, hi) * STG_PITCH + (dd * 32 + r32) * 4) = o[2 * hc + dd][r] * rli[r];
        LDS_WAIT();
#pragma unroll
        for (int i = 0; i < 4; ++i) {
            const int q = lane + 64 * i, row = q >> 3, cc = q & 7;
            const f32x4 a0 = *(const LAS f32x4*)(stg + row * STG_PITCH + cc * 32), a1 = *(const LAS f32x4*)(stg + row * STG_PITCH + cc * 32 + 16);
            const size_t tok = (size_t)(tok0 + q0 + wid * 32 + row); const int col = h * 128 + hc * 64 + cc * 8;
            const u32x4 ga = *(const u32x4*)(Tn.Z + tok * NZP + ZC_GA + col), gb = *(const u32x4*)(Tn.Z + tok * NZP + ZC_GB + col), po = *(const u32x4*)(Tn.PO + tok * D + col);
            f32x4 m0, m1;
            m0[0] = bflo(ga[0]) * a0[0] + bflo(gb[0]) * bflo(po[0]); m0[1] = bfhi(ga[0]) * a0[1] + bfhi(gb[0]) * bfhi(po[0]);
            m0[2] = bflo(ga[1]) * a0[2] + bflo(gb[1]) * bflo(po[1]); m0[3] = bfhi(ga[1]) * a0[3] + bfhi(gb[1]) * bfhi(po[1]);
            m1[0] = bflo(ga[2]) * a1[0] + bflo(gb[2]) * bflo(po[2]); m1[1] = bfhi(ga[2]) * a1[1] + bfhi(gb[2]) * bfhi(po[2]);
            m1[2] = bflo(ga[3]) * a1[2] + bflo(gb[3]) * bflo(po[3]); m1[3] = bfhi(ga[3]) * a1[3] + bfhi(gb[3]) * bfhi(po[3]);
            *(u32x4*)(Tn.MIX + tok * D + col) = pack8(m0, m1);
        }
        LDS_WAIT();
    }
    asm volatile("s_waitcnt vmcnt(0) lgkmcnt(0)\n\ts_barrier" ::: "memory");
}
struct ConvJob { const float* w_gu; const float* w_down; unsigned char* wgu8; unsigned char* wdn8; };
__device__ __forceinline__ unsigned pull(gu32* ctr, volatile LAS unsigned* slot, int tid) {
    if (tid == 0) *slot = __hip_atomic_fetch_add(ctr, 1u, RLX_AGENT);
    __syncthreads();
    const unsigned v = *slot;
    __syncthreads();
    return v;
}
template <class TR>
__device__ __forceinline__ void convert_experts(LAS char* lds, gu32* ctr, volatile LAS unsigned* slot, int tid, const TR& tr) {
    constexpr int NSTRIP_GU = NE * (2 * DFF / 128), NSTRIP_DN = NE * (D / 128), NCHUNK = (NSTRIP_GU + NSTRIP_DN) / NWAVES;
    const int wave = __builtin_amdgcn_readfirstlane(tid >> 6), lane = tid & 63;
    for (;;) {
        const unsigned c = pull(ctr, slot, tid);
        if (c >= (unsigned)NCHUNK) break;
        tr((int)c * NWAVES + wave, lds + wave * 16384, lane);
    }
    __syncthreads();
}
template <class TR>
__device__ __forceinline__ void attn_phase(LAS char* lds, const Tensors& Tn, int vcu, int tid, gu32* qctr, gu32* cctr, const TR& tr) {
    volatile LAS unsigned* slot = (volatile LAS unsigned*)(lds + MISC_OFF) + 16;
    const bool conv_first = (vcu & 15) == 15;
    if (conv_first) convert_experts(lds, cctr, slot, tid, tr);
    const int x0 = (vcu >> 5) & 7;
    for (int dx = 0; dx < 8; ++dx) {
        const int x = (x0 + dx) & 7;
        for (;;) {
            const unsigned u = pull(qctr + x * 16, slot, tid);
            if (u >= 128u) break;
            const int bh = 2 * x + (int)(u & 1u);
            attn_unit(bh >> 3, bh & 7, 63 - (int)(u >> 1), Tn, lds, tid);
        }
    }
    if (!conv_first) convert_experts(lds, cctr, slot, tid, tr);
}
}

struct Args { const void* in[22]; float* out; unsigned char* ws; int ph_lo, ph_hi; };
struct Frame {
    LAS unsigned char* lds; gu32* ctl; unsigned char* ws;
    int tid, lane, wave, vcu, G;
};

__device__ __forceinline__ void ld_row(const float* p, int lane, f32x4 (&v)[4]) {
    const f32x4* q = (const f32x4*)p + lane;
#pragma unroll
    for (int j = 0; j < 4; ++j) v[j] = q[64 * j];
}
__device__ __forceinline__ void add_row_bf16(const bf16* p, int lane, f32x4 (&v)[4]) {
    const u32x2* q = (const u32x2*)p + lane;
#pragma unroll
    for (int j = 0; j < 4; ++j) { const u32x2 w = q[64 * j]; v[j][0] += bflo(w[0]); v[j][1] += bfhi(w[0]); v[j][2] += bflo(w[1]); v[j][3] += bfhi(w[1]); }
}
__device__ __forceinline__ void ld_resid(const void* base, bool is_bf16, int row, int lane, f32x4 (&v)[4]) {
    if (is_bf16) { const u32x2* q = (const u32x2*)((const bf16*)base + (size_t)row * D) + lane;
#pragma unroll
        for (int j = 0; j < 4; ++j) { const u32x2 w = q[64 * j]; v[j] = (f32x4){bflo(w[0]), bfhi(w[0]), bflo(w[1]), bfhi(w[1])}; } }
    else ld_row((const float*)base + (size_t)row * D, lane, v);
}
__device__ __forceinline__ void st_row_bf16(bf16* p, int lane, const f32x4 (&v)[4]) {
    u32x2* q = (u32x2*)p + lane;
#pragma unroll
    for (int j = 0; j < 4; ++j) { u32x2 w = {cvtpk(v[j][0], v[j][1]), cvtpk(v[j][2], v[j][3])}; q[64 * j] = w; }
}
__device__ __forceinline__ void st_row_fp8(unsigned char* p, int lane, const f32x4 (&v)[4]) {
    unsigned* q = (unsigned*)p + lane;
#pragma unroll
    for (int j = 0; j < 4; ++j) q[64 * j] = cvt4_fp8(v[j][0], v[j][1], v[j][2], v[j][3]);
}
__device__ __forceinline__ float row_ssq(const f32x4 (&v)[4]) {
    float s = 0.f;
#pragma unroll
    for (int j = 0; j < 4; ++j) s += (v[j][0] * v[j][0] + v[j][1] * v[j][1]) + (v[j][2] * v[j][2] + v[j][3] * v[j][3]);
    return wave_sum(s);
}
__device__ __forceinline__ void adaln_row(const f32x4 (&x)[4], const float* g, const float* sc, const float* sh, int lane, f32x4 (&hout)[4]) {
    const float inv = __builtin_amdgcn_rsqf(row_ssq(x) * (1.f / D) + EPS);
    f32x4 gv[4], scv[4], shv[4]; ld_row(g, lane, gv); ld_row(sc, lane, scv); ld_row(sh, lane, shv);
#pragma unroll
    for (int j = 0; j < 4; ++j) hout[j] = (x[j] * inv) * gv[j] * (scv[j] + 1.f) + shv[j];
}

__device__ __forceinline__ void adaln_vecs(const float* g, const float* sc, const float* sh, int lane, f32x4 (&av)[4], f32x4 (&sv)[4]) {
    f32x4 gv[4], scv[4]; ld_row(g, lane, gv); ld_row(sc, lane, scv); ld_row(sh, lane, sv);
#pragma unroll
    for (int j = 0; j < 4; ++j) av[j] = gv[j] * (scv[j] + 1.f);
}
__device__ __forceinline__ void adaln_apply(const f32x4 (&x)[4], const f32x4 (&av)[4], const f32x4 (&sv)[4], f32x4 (&hout)[4]) {
    const float inv = __builtin_amdgcn_rsqf(row_ssq(x) * (1.f / D) + EPS);
#pragma unroll
    for (int j = 0; j < 4; ++j) hout[j] = (x[j] * inv) * av[j] + sv[j];
}
template <class RowMap>
__device__ __forceinline__ void tr_item(const float* W, int K, int N, bf16* WT, const RowMap& rm, const float* ks, const float* ns, float cs, LAS float* scr, int item, int lane) {
    const int nblk = N / 32, kb = item / nblk, nb = item % nblk, k0 = 64 * kb, n0 = 32 * nb;
    const float nsv = ns ? ns[n0 + (lane & 31)] * cs : cs;
#pragma unroll 8
    for (int i = 0; i < 32; ++i) { const int kk = 2 * i + (lane >> 5); float v = W[(size_t)(k0 + kk) * N + n0 + (lane & 31)] * nsv; if (ks) v *= ks[k0 + kk]; scr[kk * 33 + (lane & 31)] = v; }
    LDS_WAIT(); asm volatile("" ::: "memory");
    const int c = lane & 7;
#pragma unroll
    for (int j = 0; j < 4; ++j) { const int n = (lane >> 3) + 8 * j; const LAS float* s = scr + (8 * c) * 33 + n;
        u32x4 o; o.x = cvtpk(s[0 * 33], s[1 * 33]); o.y = cvtpk(s[2 * 33], s[3 * 33]); o.z = cvtpk(s[4 * 33], s[5 * 33]); o.w = cvtpk(s[6 * 33], s[7 * 33]);
        *(u32x4*)(WT + (size_t)rm(n0 + n) * K + k0 + 8 * c) = o; }
    LDS_WAIT(); asm volatile("" ::: "memory");
}
template <class RowMap>
__device__ __forceinline__ void tr_item8(const float* W, int K, int N, unsigned char* WT, const RowMap& rm, float cs, LAS float* scr, int item, int lane, int ldk = 0, const float* ks = nullptr) {
    if (ldk == 0) ldk = K;
    const int nblk = N / 32, kb = item / nblk, nb = item % nblk, k0 = 64 * kb, n0 = 32 * nb;
#pragma unroll 16
    for (int i = 0; i < 32; ++i) { const int kk = 2 * i + (lane >> 5); float v = W[(size_t)(k0 + kk) * N + n0 + (lane & 31)] * cs; if (ks) v *= ks[k0 + kk]; scr[kk * 33 + (lane & 31)] = v; }
    LDS_WAIT(); asm volatile("" ::: "memory");
#pragma unroll
    for (int j = 0; j < 2; ++j) { const int pr = lane + 64 * j, n = pr >> 2, c = pr & 3; const LAS float* s = scr + (16 * c) * 33 + n;
        u32x4 o; o.x = cvt4_fp8(s[0 * 33], s[1 * 33], s[2 * 33], s[3 * 33]); o.y = cvt4_fp8(s[4 * 33], s[5 * 33], s[6 * 33], s[7 * 33]);
        o.z = cvt4_fp8(s[8 * 33], s[9 * 33], s[10 * 33], s[11 * 33]); o.w = cvt4_fp8(s[12 * 33], s[13 * 33], s[14 * 33], s[15 * 33]);
        *(u32x4*)(WT + (size_t)rm(n0 + n) * ldk + k0 + 16 * c) = o; }
    LDS_WAIT(); asm volatile("" ::: "memory");
}
template <class RowMap>
__device__ __forceinline__ void tr_strip8(const float* W, int K, int N, unsigned char* WT, const RowMap& rm, float cs, LAS char* scrb, int nb, int lane) {
    const int n0 = 32 * nb, nkb = K / 64, h = lane >> 5, n = lane & 31;
    const float* src = W + (size_t)(32 * h) * N + n0 + n;
    float cur[32], nxt[32];
#pragma unroll
    for (int i = 0; i < 32; ++i) cur[i] = src[(size_t)i * N];
#pragma unroll 1
    for (int kb2 = 0; kb2 < nkb; kb2 += 2) {
#pragma unroll
        for (int par = 0; par < 2; ++par) {
            const int k0 = 64 * (kb2 + par), kn = kb2 + par + 1 < nkb ? k0 + 64 : k0;
#pragma unroll
            for (int i = 0; i < 32; ++i) nxt[i] = src[(size_t)(kn + i) * N];
            u32x4 w0, w1;
            w0.x = cvt4_fp8(cur[0] * cs, cur[1] * cs, cur[2] * cs, cur[3] * cs);     w0.y = cvt4_fp8(cur[4] * cs, cur[5] * cs, cur[6] * cs, cur[7] * cs);
            w0.z = cvt4_fp8(cur[8] * cs, cur[9] * cs, cur[10] * cs, cur[11] * cs);   w0.w = cvt4_fp8(cur[12] * cs, cur[13] * cs, cur[14] * cs, cur[15] * cs);
            w1.x = cvt4_fp8(cur[16] * cs, cur[17] * cs, cur[18] * cs, cur[19] * cs); w1.y = cvt4_fp8(cur[20] * cs, cur[21] * cs, cur[22] * cs, cur[23] * cs);
            w1.z = cvt4_fp8(cur[24] * cs, cur[25] * cs, cur[26] * cs, cur[27] * cs); w1.w = cvt4_fp8(cur[28] * cs, cur[29] * cs, cur[30] * cs, cur[31] * cs);
            LAS char* p = scrb + n * 144 + par * 64 + 32 * h;
            *(LAS u32x4*)p = w0; *(LAS u32x4*)(p + 16) = w1;
#pragma unroll
            for (int i = 0; i < 32; ++i) cur[i] = nxt[i];
        }
        LDS_WAIT(); asm volatile("" ::: "memory");
#pragma unroll
        for (int j = 0; j < 4; ++j) { const int q = lane + 64 * j, row = q >> 3, c = q & 7;
            const u32x4 o = *(const LAS u32x4*)(scrb + row * 144 + c * 16);
            *(u32x4*)(WT + (size_t)rm(n0 + row) * K + 64 * kb2 + 16 * c) = o; }
        LDS_WAIT(); asm volatile("" ::: "memory");
    }
}
template <class RowMap>
__device__ __forceinline__ void tr_strip128(const float* W, int K, int N, unsigned char* WT, const RowMap& rm, float cs, int nb, int lane) {
    const int n0 = 128 * nb, h = lane >> 5, j = lane & 31; const size_t rs = (size_t)(N / 4);
    const f32x4* src = (const f32x4*)(W + (size_t)(16 * h) * N + n0 + 4 * j);
    unsigned char* dst[4];
#pragma unroll
    for (int c = 0; c < 4; ++c) dst[c] = WT + (size_t)rm(n0 + 4 * j + c) * K + 16 * h;
    f32x4 a[16], b[16];
#pragma unroll
    for (int i = 0; i < 16; ++i) a[i] = src[(size_t)i * rs];
#pragma unroll 1
    for (int k0 = 0; k0 < K; k0 += 32) {
        const int kn = k0 + 32 < K ? k0 + 32 : k0;
#pragma unroll
        for (int i = 0; i < 16; ++i) b[i] = src[(size_t)(kn + i) * rs];
#pragma unroll
        for (int c = 0; c < 4; ++c) {
            u32x4 o;
            o.x = cvt4_fp8(a[0][c] * cs, a[1][c] * cs, a[2][c] * cs, a[3][c] * cs);     o.y = cvt4_fp8(a[4][c] * cs, a[5][c] * cs, a[6][c] * cs, a[7][c] * cs);
            o.z = cvt4_fp8(a[8][c] * cs, a[9][c] * cs, a[10][c] * cs, a[11][c] * cs);   o.w = cvt4_fp8(a[12][c] * cs, a[13][c] * cs, a[14][c] * cs, a[15][c] * cs);
            *(u32x4*)(dst[c] + k0) = o;
        }
#pragma unroll
        for (int i = 0; i < 16; ++i) a[i] = b[i];
    }
}
__device__ __forceinline__ int rope_pos(int d) { return d < 32 ? 8 * (d >> 2) + (d & 3) : 8 * ((d - 32) >> 2) + 4 + (d & 3); }
struct MapId { __device__ __forceinline__ int operator()(int n) const { return n; } };
struct MapWin { __device__ __forceinline__ int operator()(int n) const {
    if (n < 384) return ZC_CQ + n; if (n < 640) return ZC_CKV + (n - 384); if (n < 704) return ZC_KR + rope_pos(n - 640);
    if (n < 1216) return ZC_POOL + (n - 704); if (n < 2240) return ZC_GA + (n - 1216); return ZC_GB + (n - 2240); } };
struct MapUq { __device__ __forceinline__ int operator()(int n) const { const int head = n / DQK, wi = n - head * DQK; return wi < QKN ? n : head * DQK + QKN + rope_pos(wi - QKN); } };
struct MapGu { __device__ __forceinline__ int operator()(int n) const { const int which = n >> 10, j = n & 1023; return (j >> 7) * 256 + which * 128 + (j & 127); } };

__device__ __forceinline__ void prologue(Frame& F) {
    typedef __attribute__((address_space(4))) const Args* KA; KA a_ = (KA)__builtin_amdgcn_kernarg_segment_ptr(); asm volatile("" : "+s"(a_));
#define a (*a_)
    LAS float* scr = (LAS float*)(F.lds + F.wave * 16384);
    const int gw = F.vcu * NWAVES + F.wave, NGW = F.G * NWAVES, lane = F.lane;
    const float* c_in = (const float*)a.in[1]; const int* pos_in = (const int*)a.in[2];
    const float* ada_w = (const float*)a.in[3]; const float* ada_b = (const float*)a.in[4];
    const float* w_in = (const float*)a.in[7]; const float* q_norm = (const float*)a.in[8]; const float* w_uq = (const float*)a.in[9];
    const float* kv_norm = (const float*)a.in[10]; const float* w_ukv = (const float*)a.in[11]; const float* w_pool = (const float*)a.in[12];
    const float* pool_scale = (const float*)a.in[13]; const float* w_out = (const float*)a.in[14]; const float* w_router = (const float*)a.in[15];
    const float* w_gu = (const float*)a.in[17]; const float* w_down = (const float*)a.in[19];
    unsigned char* ws = F.ws;
    constexpr int I_MOD = DEPTH * (6 * D / 64);
    constexpr int I_WIN = (D / 64) * (NZ / 32), I_UQ = (QL / 64) * (NQ / 32), I_UKV = (KVL / 64) * (NKV / 32), I_POOL = 4 * (128 / 64) * (256 / 32), I_OUT = (D / 64) * (D / 32);
    constexpr int I_SMALL = DEPTH * (I_WIN + I_UQ + I_UKV + I_POOL + I_OUT);
    constexpr int I_GU1 = (D / 64) * (2 * DFF / 32), I_DN1 = (DFF / 64) * (D / 32);
    constexpr int I_GU = DEPTH * NE * I_GU1, I_DN = DEPTH * NE * I_DN1;
    constexpr int S_GU = I_GU / (D / 64), S_DN = I_DN / (DFF / 64);
    constexpr int NITEMS = I_MOD + I_SMALL;
    for (int item = F.vcu; item < I_MOD; item += F.G) {
        const int l = item / (6 * D / 64), n = (item % (6 * D / 64)) * 64 + lane, kbase = 128 * F.wave;
        const float* wp = ada_w + (size_t)l * D * 6 * D + (size_t)kbase * 6 * D + n; float a0 = 0.f, a1 = 0.f;
#pragma unroll
        for (int i = 0; i < 2; ++i) { const float c0 = c_in[kbase + 64 * i + lane], c1 = c_in[D + kbase + 64 * i + lane]; scr[64 * i + lane] = c0 * sigmoid_f(c0); scr[128 + 64 * i + lane] = c1 * sigmoid_f(c1); }
        LDS_WAIT(); asm volatile("" ::: "memory");
        for (int k0 = 0; k0 < 128; k0 += 32) { float w[32];
#pragma unroll
            for (int i = 0; i < 32; ++i) w[i] = wp[(size_t)(k0 + i) * 6 * D];
#pragma unroll
            for (int i = 0; i < 32; ++i) { a0 += w[i] * scr[k0 + i]; a1 += w[i] * scr[128 + k0 + i]; } }
        scr[1024 + lane] = a0; scr[1088 + lane] = a1;
        __syncthreads();
        if (F.wave == 0) {
            float s0 = 0.f, s1 = 0.f;
#pragma unroll
            for (int w = 0; w < NWAVES; ++w) { const LAS float* pw = (const LAS float*)(F.lds + w * 16384); s0 += pw[1024 + lane]; s1 += pw[1088 + lane]; }
            float* mod = (float*)(ws + WS_MOD) + (size_t)l * 2 * 6 * D; const float bb = ada_b[(size_t)l * 6 * D + n];
            mod[n] = s0 + bb; mod[6 * D + n] = s1 + bb; }
        __syncthreads();
    }
    for (int it = gw; it < I_SMALL; it += NGW) {
        int r = it;
        {
            const int l = r / (I_SMALL / DEPTH); r %= (I_SMALL / DEPTH);
            if (r < I_WIN) { tr_item8(w_in + (size_t)l * D * NZ, D, NZ, ws + WS_WIN + (size_t)l * NZP * D, MapWin(), W8_SCALE, scr, r, lane); continue; } r -= I_WIN;
            if (r < I_UQ) { tr_item8(w_uq + (size_t)l * QL * NQ, QL, NQ, ws + WS_WUQ + (size_t)l * NQ * CQP, MapUq(), QSCALE * W8_SCALE, scr, r, lane, CQP, q_norm + l * QL); continue; } r -= I_UQ;
            if (r < I_UKV) { tr_item8(w_ukv + (size_t)l * KVL * NKV, KVL, NKV, ws + WS_WUKV + (size_t)l * NKV * KVL, MapId(), W8_SCALE, scr, r, lane, KVL, kv_norm + l * KVL); continue; } r -= I_UKV;
            if (r < I_POOL) { const int gg = r / (I_POOL / 4), rr = r % (I_POOL / 4);
                tr_item(w_pool + ((size_t)l * 4 + gg) * 128 * 256, 128, 256, (bf16*)(ws + WS_WPOOL) + ((size_t)l * 4 + gg) * 256 * 128, MapId(), nullptr, pool_scale + ((size_t)l * 4 + gg) * 256, 1.f, scr, rr, lane); continue; } r -= I_POOL;
            tr_item(w_out + (size_t)l * D * D, D, D, (bf16*)(ws + WS_WOUT) + (size_t)l * D * D, MapId(), nullptr, nullptr, 1.f, scr, r, lane); continue; }
    }
    const int gt = F.vcu * NTHREADS + F.tid, NGT = F.G * NTHREADS;
    for (int i = gt; i < DEPTH * 64 * D / 16; i += NGT) { const int l = i / (64 * D / 16), rr = i % (64 * D / 16);
        *(u32x4*)(ws + WS_WIN + ((size_t)l * NZP + NZ) * D + (size_t)rr * 16) = (u32x4){0u, 0u, 0u, 0u}; }
    for (int i = gt; i < DEPTH * NQ * 8; i += NGT) { const int rowi = i >> 3, ch = i & 7;
        *(u32x4*)(ws + WS_WUQ + (size_t)rowi * CQP + QL + ch * 16) = (u32x4){0u, 0u, 0u, 0u}; }
    for (int i = gt; i < DEPTH * D * NE; i += NGT) { const int l = i / (D * NE), rr = i % (D * NE), k = rr / NE, e = rr % NE;
        const float w = w_router[i]; const unsigned short hb = f2bf(w); const unsigned short lb = f2bf(w - bf2f(hb));
        bf16* wr = (bf16*)(ws + WS_WR) + (size_t)l * 64 * D; wr[(size_t)e * D + k] = hb; wr[(size_t)(32 + e) * D + k] = lb; }
    for (int i = gt; i < T * 32; i += NGT) { const int t = i >> 5, f = i & 31;
        const float inv_freq = exp2f(-(float)f * 0.41524101186092029f);
        const float ang = (float)pos_in[t] * inv_freq;
        const double rev = (double)ang * 0.15915494309189535; const float fr = (float)(rev - floor(rev));
        ((float*)(ws + WS_COS))[i] = __builtin_amdgcn_cosf(fr); ((float*)(ws + WS_SIN))[i] = __builtin_amdgcn_sinf(fr); }
#undef a
}

__device__ __forceinline__ void norm1_phase(Frame& F, const float* x, const float* g, const float* mod  , unsigned char* H) {
    const int gw = F.vcu * NWAVES + F.wave, NGW = F.G * NWAVES, lane = F.lane;
    f32x4 av[4], sv[4], xn[4]; int bcur = -1;
    if (gw < T) ld_row(x + (size_t)gw * D, lane, xn);
    for (int row = gw; row < T; row += NGW) {
        const int b = row >= SEQ ? 1 : 0;
        f32x4 xv[4], hv[4];
#pragma unroll
        for (int j = 0; j < 4; ++j) xv[j] = xn[j];
        if (row + NGW < T) ld_row(x + (size_t)(row + NGW) * D, lane, xn);
        if (b != bcur) { adaln_vecs(g, mod + b * 6 * D + D, mod + b * 6 * D, lane, av, sv); bcur = b; }
        adaln_apply(xv, av, sv, hv);
        st_row_fp8(H + (size_t)row * D, lane, hv);
    }
}

__device__ __forceinline__ void pool_phase(Frame& F, const bf16* Z, const bf16* Wp  , bf16* PO) {
    constexpr int PITCH = 272;
    LAS char* Pl = (LAS char*)F.lds;
    LAS char* Bl = (LAS char*)F.lds + 34816;
    const int tid = F.tid, lane = F.lane, wid = F.wave, fr = lane & 15, fq = lane >> 4;
    const int g = F.vcu & 3, w = 2 << g, nstr = F.G >> 2;
    for (int i = tid; i < 256 * 16; i += NTHREADS) { const int n = i >> 4, ch = i & 15;
        *(LAS u32x4*)(Bl + n * PITCH + ch * 16) = *(const u32x4*)(Wp + ((size_t)g * 256 + n) * 128 + ch * 8); }
    for (int rt = F.vcu >> 2; rt < T / 128; rt += nstr) {
        const int row0 = rt * 128, s0 = row0 & (SEQ - 1);
        { const int cp = tid & 63, rc = tid >> 6;
          unsigned u[31];
          const bf16* zp = Z + (size_t)(row0 + rc * 16 - 15) * NZP + ZC_POOL + g * 128 + cp * 2;
#pragma unroll
          for (int j = 0; j < 31; ++j) u[j] = (s0 + rc * 16 - 15 + j >= 0) ? *(const unsigned*)(zp + (size_t)j * NZP) : 0u;
          float sa = 0.f, sb = 0.f;
#pragma unroll
          for (int j = 1; j < 16; ++j) { if (j < w) { sa += bflo(u[15 - j]); sb += bfhi(u[15 - j]); } }
#pragma unroll
          for (int i = 0; i < 16; ++i) { const int r = rc * 16 + i; const float ua = bflo(u[15 + i]), ub = bfhi(u[15 + i]);
              sa += ua; sb += ub;
              const int pos = s0 + r; const float cnt = (float)(pos + 1 < w ? pos + 1 : w);
              *(LAS unsigned*)(Pl + r * PITCH + cp * 4) = cvtpk(sa / cnt - ua, sb / cnt - ub);
              const unsigned ud = (g == 0) ? u[15 + i - 1] : (g == 1) ? u[15 + i - 3] : (g == 2) ? u[15 + i - 7] : u[i];
              sa -= bflo(ud); sb -= bfhi(ud); } }
        __syncthreads();
        f32x4 acc[16];
#pragma unroll
        for (int n = 0; n < 16; ++n) acc[n] = (f32x4){0.f, 0.f, 0.f, 0.f};
#pragma unroll
        for (int ks = 0; ks < 4; ++ks) {
            const bf16x8 af = *(const LAS bf16x8*)(Pl + (wid * 16 + fr) * PITCH + ks * 64 + fq * 16);
#pragma unroll
            for (int n = 0; n < 16; ++n) { const bf16x8 bfr = *(const LAS bf16x8*)(Bl + (n * 16 + fr) * PITCH + ks * 64 + fq * 16);
                acc[n] = __builtin_amdgcn_mfma_f32_16x16x32_bf16(bfr, af, acc[n], 0, 0, 0); }
        }
        { bf16* op = PO + (size_t)(row0 + wid * 16 + fr) * D + g * 256 + 4 * fq;
#pragma unroll
          for (int n = 0; n < 16; ++n) { u32x2 o = {cvtpk(acc[n][0], acc[n][1]), cvtpk(acc[n][2], acc[n][3])}; *(u32x2*)(op + n * 16) = o; } }
        __syncthreads();
    }
}

__device__ __forceinline__ void router_phase(Frame& F, const void* X1, bool xbf, const bf16* DX, const float* g, const float* mod, const bf16* Wr  , const float* brt, bf16* H, unsigned char* H8,
                                             gu32* cntw  , int* sdest, float* sw) {
    LAS float* part = (LAS float*)F.lds;
    LAS int* hist = (LAS int*)(F.lds + 16384);
    LAS int* base = (LAS int*)(F.lds + 16384 + 128);
    const int lane = F.lane, wid = F.wave, r32 = lane & 31, hi = lane >> 5;
    for (int blk = F.vcu; blk < T / 128; blk += F.G) {
        if (F.tid < 32) hist[F.tid] = 0;
        f32x4 av[4], sv[4], xn[4]; u32x2 dn[4];
        { const int b = (blk * 128) >= SEQ ? 1 : 0; adaln_vecs(g, mod + b * 6 * D + 4 * D, mod + b * 6 * D + 3 * D, lane, av, sv); }
        { const int row = blk * 128 + wid * 16; ld_resid(X1, xbf, row, lane, xn); const u32x2* dp = (const u32x2*)(DX + (size_t)row * D) + lane;
#pragma unroll
          for (int j = 0; j < 4; ++j) dn[j] = dp[64 * j]; }
        for (int i = 0; i < 16; ++i) {
            const int row = blk * 128 + wid * 16 + i;
            f32x4 xv[4], hv[4];
#pragma unroll
            for (int j = 0; j < 4; ++j) xv[j] = xn[j] + (f32x4){bflo(dn[j][0]), bfhi(dn[j][0]), bflo(dn[j][1]), bfhi(dn[j][1])};
            if (i + 1 < 16) { ld_resid(X1, xbf, row + 1, lane, xn); const u32x2* dp = (const u32x2*)(DX + (size_t)(row + 1) * D) + lane;
#pragma unroll
                for (int j = 0; j < 4; ++j) dn[j] = dp[64 * j]; }
            adaln_apply(xv, av, sv, hv);
            st_row_bf16(H + (size_t)row * D, lane, hv);
            { unsigned* q8 = (unsigned*)(H8 + (size_t)row * D) + lane;
#pragma unroll
              for (int j = 0; j < 4; ++j) q8[64 * j] = cvt4_fp8(hv[j][0], hv[j][1], hv[j][2], hv[j][3]); }
        }
        VM_WAIT(); __syncthreads();
        f32x16 lg = f32x16{};
        { const int wq = wid & 3; const bf16* wp = Wr + (size_t)((wid >> 2) * 32 + r32) * D + hi * 8; const bf16* hp = H + (size_t)(blk * 128 + wq * 32 + r32) * D + hi * 8;
#pragma unroll 8
          for (int kk = 0; kk < 64; ++kk) { const bf16x8 af = *reinterpret_cast<const bf16x8*>(wp + kk * 16), bfr = *reinterpret_cast<const bf16x8*>(hp + kk * 16);
              lg = __builtin_amdgcn_mfma_f32_32x32x16_bf16(af, bfr, lg, 0, 0, 0); } }
        if (wid >= 4) {
#pragma unroll
            for (int r = 0; r < 16; ++r) part[((wid & 3) * 16 + r) * 64 + lane] = lg[r]; }
        __syncthreads();
        if (wid < 4) {
            float v[32];
#pragma unroll
            for (int r = 0; r < 16; ++r) { const float s = lg[r] + part[(wid * 16 + r) * 64 + lane];
                auto rr = __builtin_amdgcn_permlane32_swap(__float_as_uint(s), __float_as_uint(s), false, false);
                const int e0 = (r & 3) + 8 * (r >> 2);
                v[e0] = __uint_as_float(rr[0]) + brt[e0]; v[e0 + 4] = __uint_as_float(rr[1]) + brt[e0 + 4]; }
            float tv[4]; int te[4];
#pragma unroll
            for (int k = 0; k < 4; ++k) { float best = v[0]; int bi = 0;
#pragma unroll
                for (int e = 1; e < 32; ++e) { if (v[e] > best) { best = v[e]; bi = e; } }
                tv[k] = best; te[k] = bi;
#pragma unroll
                for (int e = 0; e < 32; ++e) v[e] = (e == bi) ? -__builtin_inff() : v[e]; }
            float ex[4], den = 0.f;
#pragma unroll
            for (int k = 0; k < 4; ++k) { ex[k] = __expf(tv[k] - tv[0]); den += ex[k]; }
            const float rden = 1.f / den;
            int lr[4];
            if (hi == 0) {
#pragma unroll
                for (int k = 0; k < 4; ++k) lr[k] = __hip_atomic_fetch_add(&hist[te[k]], 1, __ATOMIC_RELAXED, __HIP_MEMORY_SCOPE_WORKGROUP); }
            __builtin_amdgcn_s_waitcnt(0);
            asm volatile("s_barrier" ::: "memory");
            if (F.tid < 32) base[F.tid] = (int)__hip_atomic_fetch_add(cntw + 64 * F.tid, (unsigned)hist[F.tid], RLX_AGENT);
            __builtin_amdgcn_s_waitcnt(0);
            asm volatile("s_barrier" ::: "memory");
            if (hi == 0) { const int tok = blk * 128 + wid * 32 + r32;
#pragma unroll
                for (int k = 0; k < 4; ++k) { const int pos = base[te[k]] + lr[k]; sdest[(size_t)te[k] * T + pos] = tok * 4 + k; sw[(size_t)te[k] * T + pos] = ex[k] * rden; } }
        } else {
            asm volatile("s_barrier" ::: "memory");
            asm volatile("s_barrier" ::: "memory");
        }
        __syncthreads();
    }
}

__device__ __forceinline__ int moe_tables(Frame& F, gu32* cntw) {
    LAS int* cnt = (LAS int*)(F.lds + TAB_OFF); LAS int* tstart = cnt + 32; LAS int* tinfo = tstart + 36;
    if (F.tid < 32) cnt[F.tid] = (int)__hip_atomic_load(cntw + 64 * F.tid, RLX_AGENT);
    __syncthreads();
    if (F.tid == 0) { int s = 0; for (int e = 0; e < 32; ++e) { tstart[e] = s; s += (cnt[e] + 255) >> 8; } tstart[32] = s; }
    __syncthreads();
    const int ntr = tstart[32];
    for (int gi = F.tid; gi < ntr; gi += NTHREADS) { int e = 0;
        for (int j = 1; j < 32; ++j) e += (tstart[j] <= gi) ? 1 : 0;
        tinfo[gi] = (e << 16) | (gi - tstart[e]); }
    __syncthreads();
    return ntr;
}

__device__ __forceinline__ void combine_phase(Frame& F, const void* X1, bool xbf, const bf16* DX, const unsigned char* Y, const float* mod, bf16* X2, bool last_layer,
                                              const float* gnext, const float* modnext, unsigned char* H, const float* gfinal, float* out) {
    const int gw = F.vcu * NWAVES + F.wave, NGW = F.G * NWAVES, lane = F.lane;
    for (int row = gw; row < T; row += NGW) {
        const int b = row >= SEQ ? 1 : 0;
        f32x4 xv[4], gf[4], ys[4]; ld_resid(X1, xbf, row, lane, xv); add_row_bf16(DX + (size_t)row * D, lane, xv); ld_row(mod + b * 6 * D + 5 * D, lane, gf);
#pragma unroll
        for (int j = 0; j < 4; ++j) ys[j] = (f32x4){0.f, 0.f, 0.f, 0.f};
#pragma unroll
        for (int k = 0; k < 4; ++k) { const unsigned* yp = (const unsigned*)(Y + ((size_t)row * 4 + k) * D) + lane;
#pragma unroll
            for (int j = 0; j < 4; ++j) { const int w = (int)yp[64 * j]; const f32x2 lo = __builtin_amdgcn_cvt_pk_f32_fp8(w, false), hi2 = __builtin_amdgcn_cvt_pk_f32_fp8(w, true);
                ys[j][0] += lo[0]; ys[j][1] += lo[1]; ys[j][2] += hi2[0]; ys[j][3] += hi2[1]; } }
#pragma unroll
        for (int j = 0; j < 4; ++j) xv[j] = xv[j] + gf[j] * ys[j];
        if (!last_layer) {
            st_row_bf16(X2 + (size_t)row * D, lane, xv);
            f32x4 hv[4]; adaln_row(xv, gnext, modnext + b * 6 * D + D, modnext + b * 6 * D, lane, hv);
            st_row_fp8(H + (size_t)row * D, lane, hv);
        } else {
            const float inv = __builtin_amdgcn_rsqf(row_ssq(xv) * (1.f / D) + EPS);
            f32x4 gv[4]; ld_row(gfinal, lane, gv);
            f32x4* oo = (f32x4*)(out + (size_t)row * D) + lane;
#pragma unroll
            for (int j = 0; j < 4; ++j) oo[64 * j] = (xv[j] * inv) * gv[j];
        }
    }
}

typedef __attribute__((address_space(4))) const Args* KArgs;
__device__ __forceinline__ KArgs kargs() { KArgs p = (KArgs)__builtin_amdgcn_kernarg_segment_ptr(); asm volatile("" : "+s"(p)); return p; }
__device__ __forceinline__ Frame make_frame(unsigned char* lds_raw) {
    Frame F; KArgs ap = kargs();
    int tid = threadIdx.x; asm volatile("" : "+v"(tid));
    F.lds = (LAS unsigned char*)lds_raw; F.ws = ap->ws; F.ctl = (gu32*)(F.ws + WS_CTL);
    F.tid = tid; F.lane = tid & 63; F.wave = __builtin_amdgcn_readfirstlane(tid >> 6);
    F.G = gridDim.x; { const int bx = blockIdx.x; F.vcu = (F.G % 8 == 0) ? (bx % 8) * (F.G / 8) + bx / 8 : bx; }
    return F;
}
#define INP(i) ((const float*)ap->in[i])
__global__ void __launch_bounds__(NTHREADS, 2) fwd_kernel(Args args) {
    extern __shared__ __attribute__((aligned(16))) unsigned char lds_raw[];
    volatile LAS unsigned* MISC = (volatile LAS unsigned*)((LAS unsigned char*)lds_raw + MISC_OFF);
    if (threadIdx.x < 64) MISC[threadIdx.x] = 0u;
    __syncthreads();
    XcdBarrier bar; bar.bar = (unsigned*)(args.ws + WS_CTL) + CW_BAR; bar.x = 0; bar.st = nullptr;
    if (N_LAUNCHES == 1) bar = xcd_barrier_post((unsigned*)(args.ws + WS_CTL) + CW_BAR, MISC + 8);
    const int lo = args.ph_lo, hi = args.ph_hi;
#define IN(k) (lo <= (k) && (k) < hi)
#define SEAM(k) do { if (IN(k) && IN((k) + 1)) { XcdBarrier b2_ = bar; asm volatile("" : "+s"(b2_.bar)); xcd_barrier(b2_); } } while (0)

    if (IN(0)) REP(8) { Frame F = make_frame(lds_raw); prologue(F); }
    SEAM(0);
    if (IN(1)) REP(9) { Frame F = make_frame(lds_raw); KArgs ap = kargs(); norm1_phase(F, INP(0), INP(5), (const float*)(F.ws + WS_MOD), F.ws + WS_H8); }
    SEAM(1);
    for (int l = 0; l < DEPTH; ++l) {
        const int pb = 2 + 8 * l;
        if (IN(pb + 0)) REP(0) {
            Frame F = make_frame(lds_raw); unsigned char* ws = F.ws;
            pg8::Gemm g{(const bf16*)(ws + WS_H8), (const bf16*)(ws + WS_WIN + (size_t)l * NZP * D), D / 2, D / 2};
            pg8::StaticOrder S; S.init(T / 256, NZP / 256, F.G, (int)blockIdx.x);
            pg8::EpiZ E{(bf16*)(ws + WS_Z), ws + WS_KR, (float*)(ws + WS_RSQ), (float*)(ws + WS_RSKV), (const float*)(ws + WS_COS), (const float*)(ws + WS_SIN), ws + WS_CQ8, ws + WS_CKV8};
            pg8::gemm_phase<pg8::EpiZ, pg8::StaticOrder, false, true, false, 1>(F.lds, g, S, E, F.tid);
        }
        SEAM(pb + 0);
        if (IN(pb + 1)) REP(1) {
            int par_; { Frame F0 = make_frame(lds_raw); par_ = F0.vcu & 1; }
#pragma unroll 1
            for (int st = 0; st < 3; ++st) {
                const int job = par_ ? (st == 0 ? 2 : st - 1) : st;
                if (job == 0) REP(10) { Frame F = make_frame(lds_raw); unsigned char* ws = F.ws;
                  pg8::Gemm g{(const bf16*)(ws + WS_CQ8), (const bf16*)(ws + WS_WUQ + (size_t)l * NQ * CQP), CQP / 2, CQP / 2};
                  pg8::StaticOrder S; S.init(T / 256, NQ / 256, F.G, (int)blockIdx.x);
                  pg8::EpiQ E{ws + WS_Q, (const float*)(ws + WS_RSQ), (const float*)(ws + WS_COS), (const float*)(ws + WS_SIN)};
                  pg8::gemm_phase<pg8::EpiQ, pg8::StaticOrder, false, true>(F.lds, g, S, E, F.tid); }
                else if (job == 1) REP(11) { Frame F = make_frame(lds_raw); unsigned char* ws = F.ws;
                  pg8::Gemm g{(const bf16*)(ws + WS_CKV8), (const bf16*)(ws + WS_WUKV + (size_t)l * NKV * KVL), KVL / 2, KVL / 2};
                  pg8::StaticOrder S; S.init(T / 256, NKV / 256, F.G, (int)blockIdx.x);
                  pg8::EpiKV E{ws + WS_KN, ws + WS_V, (const float*)(ws + WS_RSKV)};
                  pg8::gemm_phase<pg8::EpiKV, pg8::StaticOrder, false, true, true>(F.lds, g, S, E, F.tid); }
                else REP(12) { Frame F = make_frame(lds_raw); unsigned char* ws = F.ws;
                  pool_phase(F, (const bf16*)(ws + WS_Z), (const bf16*)(ws + WS_WPOOL) + (size_t)l * 4 * 256 * 128, (bf16*)(ws + WS_PO)); }
                asm volatile("s_waitcnt vmcnt(0) lgkmcnt(0)" ::: "memory"); __syncthreads();
            }
        }
        SEAM(pb + 1);
        if (IN(pb + 2)) REP(2) {
            Frame F = make_frame(lds_raw); unsigned char* ws = F.ws;
            const att::Tensors Tn{ws + WS_Q, ws + WS_KN, ws + WS_KR, ws + WS_V, (const bf16*)(ws + WS_Z), (const bf16*)(ws + WS_PO), (bf16*)(ws + WS_MIX)};
            KArgs ap = kargs();
            const float* wgu_l = INP(17) + (size_t)l * NE * D * 2 * DFF; const float* wdn_l = INP(19) + (size_t)l * NE * DFF * D;
            unsigned char* wgu8 = ws + WS_WGU + (size_t)l * NE * 2 * DFF * D; unsigned char* wdn8 = ws + WS_WDN + (size_t)l * NE * D * DFF;
            auto tr = [=](int strip, LAS char* scrb, int lane) {
                (void)scrb;
                if (strip < NE * (2 * DFF / 128)) { const int e = strip / (2 * DFF / 128), nb = strip % (2 * DFF / 128);
                    tr_strip128(wgu_l + (size_t)e * D * 2 * DFF, D, 2 * DFF, wgu8 + (size_t)e * 2 * DFF * D, MapGu(), W8_SCALE, nb, lane); }
                else { const int s2 = strip - NE * (2 * DFF / 128), e = s2 / (D / 128), nb = s2 % (D / 128);
                    tr_strip128(wdn_l + (size_t)e * DFF * D, DFF, D, wdn8 + (size_t)e * D * DFF, MapId(), W8_SCALE, nb, lane); } };
            att::attn_phase((LAS char*)F.lds, Tn, F.vcu, F.tid, F.ctl + CW_ATTQ + l * 8 * 16, F.ctl + CW_CONV + l * 16, tr);
        }
        SEAM(pb + 2);
        if (IN(pb + 3)) REP(3) {
            Frame F = make_frame(lds_raw); unsigned char* ws = F.ws; KArgs ap = kargs();
            pg8::Gemm g{(const bf16*)(ws + WS_MIX), (const bf16*)(ws + WS_WOUT) + (size_t)l * D * D, D, D};
            pg8::StaticOrder S; S.init(T / 256, D / 256, F.G, (int)blockIdx.x);
            pg8::EpiOut E{(bf16*)(ws + WS_X1), (const float*)(ws + WS_MOD) + (size_t)l * 2 * 6 * D + 2 * D};
            pg8::gemm_phase<pg8::EpiOut, pg8::StaticOrder, false, false, false, 1>(F.lds, g, S, E, F.tid);
        }
        SEAM(pb + 3);
        if (IN(pb + 4)) {
            Frame F = make_frame(lds_raw); unsigned char* ws = F.ws; KArgs ap = kargs();
            router_phase(F, (l == 0) ? (const void*)INP(0) : (const void*)(ws + WS_X2), l != 0, (const bf16*)(ws + WS_X1), INP(6) + (size_t)l * D, (const float*)(ws + WS_MOD) + (size_t)l * 2 * 6 * D, (const bf16*)(ws + WS_WR) + (size_t)l * 64 * D, INP(16) + l * NE,
                         (bf16*)(ws + WS_H), ws + WS_H8, F.ctl + CW_CNT + l * 32 * 64, (int*)(ws + WS_SDEST), (float*)(ws + WS_SW));
        }
        SEAM(pb + 4);
        if (IN(pb + 5)) REP(5) {
            Frame F = make_frame(lds_raw); unsigned char* ws = F.ws; KArgs ap = kargs();
            const int ntr = moe_tables(F, F.ctl + CW_CNT + l * 32 * 64);
            pg8::Gemm g{(const bf16*)(ws + WS_H8), (const bf16*)(ws + WS_WGU + (size_t)l * NE * 2 * DFF * D), D / 2, D / 2};
            pg8::MoeOrder S; S.nM = ntr; S.nN = 8; S.nwg = ntr * 8; S.G = F.G; S.c = (int)blockIdx.x;
            S.tinfo = (const LAS int*)(F.lds + TAB_OFF) + 68; S.cnt = (const LAS int*)(F.lds + TAB_OFF); S.sdest = (const int*)(ws + WS_SDEST);
            pg8::EpiGU E{ws + WS_ACT, INP(18) + (size_t)l * NE * 2 * DFF};
            pg8::gemm_phase<pg8::EpiGU, pg8::MoeOrder, true, true>(F.lds, g, S, E, F.tid);
        }
        SEAM(pb + 5);
        if (IN(pb + 6)) REP(6) {
            Frame F = make_frame(lds_raw); unsigned char* ws = F.ws; KArgs ap = kargs();
            const int ntr = moe_tables(F, F.ctl + CW_CNT + l * 32 * 64);
            pg8::Gemm g{(const bf16*)(ws + WS_ACT), (const bf16*)(ws + WS_WDN + (size_t)l * NE * D * DFF), DFF / 2, DFF / 2};
            pg8::MoeOrder S; S.nM = ntr; S.nN = 4; S.nwg = ntr * 4; S.G = F.G; S.c = (int)blockIdx.x;
            S.tinfo = (const LAS int*)(F.lds + TAB_OFF) + 68; S.cnt = (const LAS int*)(F.lds + TAB_OFF); S.sdest = (const int*)(ws + WS_SDEST);
            pg8::EpiDown E{ws + WS_Y, INP(20) + (size_t)l * NE * D, (const int*)(ws + WS_SDEST), (const float*)(ws + WS_SW)};
            pg8::gemm_phase<pg8::EpiDown, pg8::MoeOrder, false, true, false, 2>(F.lds, g, S, E, F.tid);
        }
        SEAM(pb + 6);
        if (IN(pb + 7)) REP(7) {
            Frame F = make_frame(lds_raw); unsigned char* ws = F.ws; KArgs ap = kargs();
            const bool lastl = (l == DEPTH - 1); const int ln = lastl ? l : l + 1;
            combine_phase(F, (l == 0) ? (const void*)INP(0) : (const void*)(ws + WS_X2), l != 0, (const bf16*)(ws + WS_X1), ws + WS_Y, (const float*)(ws + WS_MOD) + (size_t)l * 2 * 6 * D, (bf16*)(ws + WS_X2), lastl,
                          INP(5) + (size_t)ln * D, (const float*)(ws + WS_MOD) + (size_t)ln * 2 * 6 * D, ws + WS_H8, INP(21), ap->out);
        }
        SEAM(pb + 7);
    }
#undef IN
#undef SEAM
}

extern "C" void kernel_launch(void* const* d_in, const int* in_sizes, int n_in, void* d_out, int out_size, void* d_ws, size_t ws_size, hipStream_t stream) {
    static int grid = 0;
    if (grid == 0) {
        if (n_in != 22 || in_sizes[0] != T * D || out_size != T * D || ws_size < WS_END) {
            fprintf(stderr, "kernel_launch: unexpected shapes (n_in %d, in0 %d, out %d, ws %zu < %zu)\n", n_in, n_in > 0 ? in_sizes[0] : -1, out_size, ws_size, (size_t)WS_END); grid = -1; return; }
        int dev = 0, cus = 0, per_cu = 0;
        if (hipGetDevice(&dev) != hipSuccess || hipDeviceGetAttribute(&cus, hipDeviceAttributeMultiprocessorCount, dev) != hipSuccess) { grid = -1; return; }
        if (hipFuncSetAttribute((const void*)fwd_kernel, hipFuncAttributeMaxDynamicSharedMemorySize, LDS_BYTES) != hipSuccess) { fprintf(stderr, "kernel_launch: hipFuncSetAttribute failed\n"); grid = -1; return; }
        if (hipOccupancyMaxActiveBlocksPerMultiprocessor(&per_cu, (const void*)fwd_kernel, NTHREADS, LDS_BYTES) != hipSuccess || per_cu < 1)
            fprintf(stderr, "kernel_launch: occupancy query reports %d\n", per_cu);
        (void)hipGetLastError();
        grid = cus;
    }
    if (grid < 0) return;
    if (hipMemsetAsync((char*)d_ws + WS_CTL, 0, CTL_ZERO_BYTES, stream) != hipSuccess) return;
    Args a{};
    for (int i = 0; i < 22; ++i) a.in[i] = d_in[i];
    a.out = (float*)d_out; a.ws = (unsigned char*)d_ws;
    if (N_LAUNCHES == 1) {
        a.ph_lo = 0; a.ph_hi = NPHASE;
        hipLaunchKernelGGL(fwd_kernel, dim3(grid), dim3(NTHREADS), LDS_BYTES, stream, a);
    } else {
        for (int p = 0; p < NPHASE; ++p) { a.ph_lo = p; a.ph_hi = p + 1; hipLaunchKernelGGL(fwd_kernel, dim3(grid), dim3(NTHREADS), LDS_BYTES, stream, a); }
    }
}
```

```cpp
#include <hip/hip_runtime.h>
#include <cstdio>
#include <cstdint>

#ifndef PROBE_DUP
#define PROBE_DUP -1
#endif
#define REP(k) for (int rep_ = 0; rep_ < ((PROBE_DUP == (k)) ? 2 : 1); ++rep_)
#ifndef MK_N_LAUNCHES
#define MK_N_LAUNCHES 1
#endif

constexpr int BATCH = 2, SEQ = 16384, T = BATCH * SEQ, D = 1024, DEPTH = 2;
constexpr int NH = 8, QKN = 128, QKR = 64, DQK = 192, DV = 128, QL = 384, KVL = 256;
constexpr int PW = 512, NZ = 3264, NZP = 3328;
constexpr int NQ = NH * DQK;
constexpr int NKV = NH * (QKN + DV);
constexpr int NE = 32, TOPK = 4, DFF = 1024;
constexpr float EPS = 1e-6f;
constexpr float QSCALE = 0.07216878364870322f * 1.4426950408889634f * 8.f;
constexpr int ZC_GA = 0, ZC_GB = 1024, ZC_POOL = 2048, ZC_CQ = 2560, ZC_CKV = 2944, ZC_KR = 3200;

constexpr int NWAVES = 8, NTHREADS = 512;
constexpr int NPHASE = 2 + 8 * DEPTH;
constexpr int N_LAUNCHES = MK_N_LAUNCHES;

constexpr size_t MiB = 1u << 20;
constexpr size_t WS_CTL = 0, CTL_ZERO_BYTES = 1 * MiB;
constexpr size_t WS_MOD = 1 * MiB;
constexpr size_t WS_COS = 2 * MiB, WS_SIN = 6 * MiB;
constexpr size_t WS_RSQ = 10 * MiB, WS_RSKV = 11 * MiB;
constexpr size_t WS_WUQ = 12 * MiB;
constexpr size_t WS_WUKV = 15 * MiB;
constexpr size_t WS_WPOOL = 17 * MiB;
constexpr size_t WS_WOUT = 18 * MiB;
constexpr size_t WS_WR = 22 * MiB;
constexpr size_t WS_WIN = 24 * MiB;
constexpr size_t WS_WGU = 40 * MiB;
constexpr size_t WS_WDN = 296 * MiB;
constexpr size_t WS_H8 = 360 * MiB;
constexpr float W8_SCALE = 32.f, W8_INV = 1.f / 32.f;
constexpr size_t WS_SDEST = 424 * MiB, WS_SW = 428 * MiB;
constexpr size_t WS_X1 = 1188 * MiB  , WS_X2 = 560 * MiB;
constexpr size_t WS_H = 1252 * MiB;
constexpr size_t WS_CQ8 = 688 * MiB, WS_CKV8 = 704 * MiB;
constexpr int CQP = 512;
constexpr size_t WS_Z = 752 * MiB;
constexpr size_t WS_Q = 960 * MiB;
constexpr size_t WS_KN = 1056 * MiB, WS_V = 1120 * MiB;
constexpr size_t WS_KR = 1184 * MiB;
constexpr size_t WS_PO = 1188 * MiB;
constexpr size_t WS_MIX = 1252 * MiB;
constexpr int ACT_ROWS = (T * TOPK / 256 + NE) * 256;
constexpr size_t WS_ACT = 752 * MiB;
constexpr size_t WS_Y = 888 * MiB;
constexpr size_t WS_END = 1316 * MiB;

constexpr int CW_TMO = 0;
constexpr int CW_BAR = 4096;
constexpr int CW_ATTQ = 24576;
constexpr int CW_CONV = 28672;
constexpr int CW_CNT = 16384;

constexpr int RING_BYTES = 131072;
constexpr int MISC_OFF = RING_BYTES;
constexpr int TAB_OFF = RING_BYTES + 256;
constexpr int NTR_MAX = T * TOPK / 256 + NE;
constexpr int LDS_BYTES = 147456;

#define GAS __attribute__((address_space(1)))
#define LAS __attribute__((address_space(3)))
typedef unsigned short bf16;
typedef unsigned u32x4 __attribute__((ext_vector_type(4)));
typedef unsigned u32x2 __attribute__((ext_vector_type(2)));
typedef float f32x4 __attribute__((ext_vector_type(4)));
typedef float f32x2 __attribute__((ext_vector_type(2)));
typedef float f32x16 __attribute__((ext_vector_type(16)));
typedef short bf16x8 __attribute__((ext_vector_type(8)));
typedef short s16x4 __attribute__((ext_vector_type(4)));
typedef GAS unsigned gu32;
#define RLX_AGENT __ATOMIC_RELAXED, __HIP_MEMORY_SCOPE_AGENT
#define LDS_WAIT() asm volatile("s_waitcnt lgkmcnt(0)" ::: "memory")
#define VM_WAIT() asm volatile("s_waitcnt vmcnt(0)" ::: "memory")
#define SBAR() __builtin_amdgcn_sched_barrier(0)

__device__ __forceinline__ unsigned cvtpk(float lo, float hi) { unsigned r; asm volatile("v_cvt_pk_bf16_f32 %0, %1, %2" : "=v"(r) : "v"(lo), "v"(hi)); return r; }
__device__ __forceinline__ u32x4 pack8(f32x4 a, f32x4 b) { u32x4 w = {cvtpk(a[0], a[1]), cvtpk(a[2], a[3]), cvtpk(b[0], b[1]), cvtpk(b[2], b[3])}; return w; }
__device__ __forceinline__ float bf2f(unsigned short h) { return __builtin_bit_cast(float, (unsigned)h << 16); }
__device__ __forceinline__ float bflo(unsigned w) { return __builtin_bit_cast(float, w << 16); }
__device__ __forceinline__ float bfhi(unsigned w) { return __builtin_bit_cast(float, w & 0xffff0000u); }
__device__ __forceinline__ unsigned short f2bf(float f) { return (unsigned short)(cvtpk(f, 0.f) & 0xffffu); }
typedef int i32x8 __attribute__((ext_vector_type(8)));
typedef int i32x4 __attribute__((ext_vector_type(4)));
__device__ __forceinline__ unsigned cvt4_fp8(float a, float b, float c, float d) { int w; asm volatile("" : "=v"(w));
    w = __builtin_amdgcn_cvt_pk_fp8_f32(a, b, w, false); w = __builtin_amdgcn_cvt_pk_fp8_f32(c, d, w, true); return (unsigned)w; }
__device__ __forceinline__ float sigmoid_f(float x) { return __builtin_amdgcn_rcpf(1.f + __builtin_amdgcn_exp2f(-1.4426950408889634f * x)); }
__device__ __forceinline__ float wave_sum(float v) {
#pragma unroll
    for (int o = 1; o < 64; o <<= 1) v += __shfl_xor(v, o);
    return v;
}

#define XB_TMO      128
#define XB_XCNT(j)  (256  + 64 * (j))
#define XB_XSUB(j)  (1280 + 64 * (j))
#define XB_XGEN(j)  (2304 + 64 * (j))
#define XB_TOP      3328
#define XB_TOPGEN   3392
#define XCD_BAR_WORDS 3456
#define XB_SPIN_CAP (1u << 18)

__device__ __forceinline__ unsigned xb_ld(unsigned* p)              { return __hip_atomic_load(p, __ATOMIC_RELAXED, __HIP_MEMORY_SCOPE_AGENT); }
__device__ __forceinline__ unsigned xb_add(unsigned* p, unsigned v) { return __hip_atomic_fetch_add(p, v, __ATOMIC_RELAXED, __HIP_MEMORY_SCOPE_AGENT); }
__device__ __forceinline__ unsigned xb_xcc_id() { return (unsigned)__builtin_amdgcn_s_getreg((3 << 11) | 20) & 0xFu; }
#define XB_SPIN(cond, bar) do { unsigned _sp = 0; while (cond) { __builtin_amdgcn_s_sleep(1); \
    if ((++_sp & 255u) == 0u) { if (xb_ld(&(bar)[XB_TMO])) break; if (_sp > XB_SPIN_CAP) { atomicAdd(&(bar)[XB_TMO], 1u); break; } } } } while (0)

struct XcdBarrier { unsigned* bar; unsigned x; volatile LAS unsigned* st; };

__device__ __forceinline__ XcdBarrier xcd_barrier_post(unsigned* bar, volatile LAS unsigned* st) {
    XcdBarrier b; b.bar = bar; b.x = xb_xcc_id(); b.st = st;
    if (threadIdx.x == 0) (void)xb_add(&bar[XB_XCNT(b.x)], 1u);
    return b;
}
__device__ __forceinline__ void xcd_barrier_complete(unsigned* bar, unsigned x, unsigned& nloc, unsigned& nx) {
    const unsigned G = gridDim.x * gridDim.y * gridDim.z;
    unsigned sum, cnt, mine, sp = 0u;
    for (;;) {
        sum = 0u; cnt = 0u; mine = 0u;
#pragma unroll
        for (unsigned j = 0; j < 16; ++j) { const unsigned c = xb_ld(&bar[XB_XCNT(j)]); sum += c; cnt += (c > 0u) ? 1u : 0u; mine = (j == x) ? c : mine; }
        if (sum == G) break;
        __builtin_amdgcn_s_sleep(1);
        if ((++sp & 255u) == 0u) { if (xb_ld(&bar[XB_TMO])) break; if (sp > XB_SPIN_CAP) { atomicAdd(&bar[XB_TMO], 1u); break; } }
    }
    nloc = mine > 0u ? mine : 1u; nx = cnt > 0u ? cnt : 1u;
}
__device__ __forceinline__ void xcd_barrier(const XcdBarrier& b) {
    asm volatile("s_waitcnt vmcnt(0)" ::: "memory");
    __syncthreads();
    if (threadIdx.x == 0) {
        unsigned* bar = b.bar;
        __builtin_amdgcn_s_waitcnt(0);
        unsigned nloc = b.st[0], nx = b.st[1];
        if (nloc == 0u) { xcd_barrier_complete(bar, b.x, nloc, nx); b.st[0] = nloc; b.st[1] = nx; }
        const unsigned old = xb_add(&bar[XB_XSUB(b.x)], 1u);
        const unsigned gen = old / nloc;
        if (old + 1u == (gen + 1u) * nloc) {
            __builtin_amdgcn_fence(__ATOMIC_RELEASE, "agent");
            asm volatile("s_waitcnt vmcnt(0)" ::: "memory");
            const unsigned og = xb_add(&bar[XB_TOP], 1u);
            const unsigned tg = og / nx;
            if (og + 1u == (tg + 1u) * nx) xb_add(&bar[XB_TOPGEN], 1u);
            else XB_SPIN(xb_ld(&bar[XB_TOPGEN]) == tg, bar);
            __builtin_amdgcn_fence(__ATOMIC_ACQUIRE, "agent");
            xb_add(&bar[XB_XGEN(b.x)], 1u);
            asm volatile("s_waitcnt vmcnt(0)" ::: "memory");
        } else {
            XB_SPIN(xb_ld(&bar[XB_XGEN(b.x)]) == gen, bar);
            __builtin_amdgcn_fence(__ATOMIC_ACQUIRE, "agent");
            asm volatile("s_waitcnt vmcnt(0)" ::: "memory");
        }
    }
    __syncthreads();
}

namespace pg8 {
constexpr int BM = 256, BK = 64, HALF = 128, HTB = HALF * BK * 2, STAGE_BYTES = 8 * HTB, NXCD = 8, WGM = 8;
__host__ __device__ __forceinline__ int lds_byte(int r, int c) { const int st = (r >> 4) * 2 + (c >> 5), rr = r & 15, cc = c & 31, ob = rr * 64 + cc * 2; return st * 1024 + (ob ^ (((ob >> 9) & 1) << 5)); }
__host__ __device__ __forceinline__ void stage_rc(int b, int& R, int& C) { const int st = b / 1024, sb = b % 1024, swz = sb ^ (((sb >> 9) & 1) << 5); R = (st >> 1) * 16 + swz / 64; C = (st & 1) * 32 + (swz % 64) / 2; }
__host__ __device__ __forceinline__ int perm32(int rho) { const int n = rho >> 4, i = rho & 15; return 8 * (i >> 2) + 4 * n + (i & 3); }

struct Unit { int pm, pn, e, r0, cnt; };
struct Gemm { const bf16* A; const bf16* Bt; int lda, K; };

__device__ __forceinline__ void tile_of(int wgid, int nM, int nN, int& pm, int& pn) {
    const int nwg = nM * nN;
    { const int q = nwg / NXCD, r = nwg % NXCD, xcd = wgid % NXCD, off = wgid / NXCD; wgid = (xcd < r ? xcd * (q + 1) : r * (q + 1) + (xcd - r) * q) + off; }
    const int nig = WGM * nN, gid = wgid / nig, fm = gid * WGM, gsz = (nM - fm) < WGM ? (nM - fm) : WGM;
    pm = fm + ((wgid % nig) % gsz); pn = (wgid % nig) / gsz;
}
struct StaticOrder {
    int nM, nN, nwg, G, c;
    __device__ __forceinline__ void init(int nM_, int nN_, int G_, int c_) { nM = nM_; nN = nN_; nwg = nM * nN; G = G_; c = c_; }
    __device__ __forceinline__ bool next(int i, Unit& u) const {
        const long L = (long)i * G + c; if (L >= nwg) return false;
        tile_of((int)L, nM, nN, u.pm, u.pn); u.e = 0; u.r0 = 0; u.cnt = 0; return true;
    }
    __device__ __forceinline__ int arow(const Unit&, int) const { return 0; }
};
struct MoeOrder {
    int nM, nN, nwg, G, c; const LAS int* tinfo; const LAS int* cnt; const int* sdest;
    __device__ __forceinline__ bool next(int i, Unit& u) const {
        const long L = (long)i * G + c; if (L >= nwg) return false;
        int pnl; tile_of((int)L, nM, nN, u.pm, pnl);
        const int ti = tinfo[u.pm]; u.e = ti >> 16; u.r0 = (ti & 0xffff) * 256; u.cnt = cnt[u.e]; u.pn = u.e * nN + pnl; return true;
    }
    __device__ __forceinline__ int arow(const Unit& u, int r) const {
        const int pos = u.r0 + r; int d = 0;
        if (pos < u.cnt) d = sdest[(size_t)u.e * T + pos] >> 2;
        return d;
    }
};

template <class Epi, class Sched, bool GATHER, bool FP8 = false, bool VT = false, int WIDE = 0>
__device__ __forceinline__ void gemm_phase(LAS unsigned char* lds, const Gemm g, const Sched& S, const Epi& E, int tid) {
    const int wid = __builtin_amdgcn_readfirstlane(tid >> 6), lane = tid & 63, wr = wid >> 2, wc = wid & 3, fr = lane & 15, fq = lane >> 4;
    const int K = g.K, nt = K / BK, lda = g.lda;
    unsigned voffB2[2][2];
#pragma unroll
    for (int h = 0; h < 2; ++h)
#pragma unroll
        for (int i = 0; i < 2; ++i) { int R, C; stage_rc(tid * 16 + i * 8192, R, C);
            const int p32 = perm32(R & 31);
            const int Rb = WIDE == 2 ? (64 * (R >> 5) + 16 * (p32 >> 3) + 8 * h + (p32 & 7)) : WIDE == 1 ? (64 * (R >> 5) + 32 * h + p32) : (HALF * h + (R & ~31) + p32); voffB2[h][i] = (unsigned)(Rb * K + C) * 2u; }
    const size_t kstep = (size_t)(BK * 2);
    const size_t hstepB = (size_t)HALF * K * 2;
    const size_t tstepB = 2 * hstepB;
    const unsigned ldsw = (unsigned)wid * 1024u, ldsb = (unsigned)(uintptr_t)lds;
    const int aoff = lds_byte(wr * 64 + fr, fq * 8), boff = lds_byte(wc * 32 + fr, fq * 8);
#define PG8_SA(b, h) (((b) * 2 + (h)) * HTB)
#define PG8_SB(b, h) ((4 + (b) * 2 + (h)) * HTB)
#define PG8_STAGE(bufoff, gbase, voff) do { _Pragma("unroll") for (int _i = 0; _i < 2; ++_i) { unsigned keep_; \
        asm volatile("s_mov_b32 %0, m0\n\ts_mov_b32 m0, %3\n\ts_nop 0\n\tglobal_load_lds_dwordx4 %1, %2\n\ts_mov_b32 m0, %0" : "=&s"(keep_) : "v"((voff)[_i]), "s"((const char*)(gbase)), "s"(ldsb + (unsigned)(bufoff) + ldsw + (unsigned)(_i * 8192)) : "memory"); } } while (0)
#define PG8_LDA(dst, b, h) do { _Pragma("unroll") for (int m = 0; m < 4; ++m) _Pragma("unroll") for (int k = 0; k < 2; ++k) dst[m][k] = *(const LAS bf16x8*)(lds + PG8_SA(b, h) + aoff + m * 2048 + k * 1024); } while (0)
#define PG8_LDB(dst, b, h) do { _Pragma("unroll") for (int n = 0; n < 2; ++n) _Pragma("unroll") for (int k = 0; k < 2; ++k) dst[n][k] = *(const LAS bf16x8*)(lds + PG8_SB(b, h) + boff + n * 2048 + k * 1024); } while (0)
#define PG8_CAT(x0, x1) __builtin_shufflevector(__builtin_bit_cast(i32x4, x0), __builtin_bit_cast(i32x4, x1), 0, 1, 2, 3, 4, 5, 6, 7)
#define PG8_MMA(ai, bj, At, Bt) do { __builtin_amdgcn_s_setprio(1); _Pragma("unroll") for (int m = 0; m < 4; ++m) _Pragma("unroll") for (int n = 0; n < 2; ++n) { \
        if constexpr (FP8 && VT && (bj) == 1) { asm volatile("v_mfma_f32_16x16x128_f8f6f4 %0, %1, %2, %0" : "+v"(acc[ai][bj][m][n]) : "v"(PG8_CAT(At[m][0], At[m][1])), "v"(PG8_CAT(Bt[n][0], Bt[n][1]))); } \
        else if constexpr (FP8) { asm volatile("v_mfma_f32_16x16x128_f8f6f4 %0, %1, %2, %0" : "+v"(acc[ai][bj][m][n]) : "v"(PG8_CAT(Bt[n][0], Bt[n][1])), "v"(PG8_CAT(At[m][0], At[m][1]))); } \
        else if constexpr (VT && (bj) == 1) { _Pragma("unroll") for (int k = 0; k < 2; ++k) acc[ai][bj][m][n] = __builtin_amdgcn_mfma_f32_16x16x32_bf16(At[m][k], Bt[n][k], acc[ai][bj][m][n], 0, 0, 0); } \
        else { _Pragma("unroll") for (int k = 0; k < 2; ++k) acc[ai][bj][m][n] = __builtin_amdgcn_mfma_f32_16x16x32_bf16(Bt[n][k], At[m][k], acc[ai][bj][m][n], 0, 0, 0); } } \
        __builtin_amdgcn_s_setprio(0); } while (0)
#define PG8_WAIT_V(n) asm volatile("s_waitcnt vmcnt(" #n ")" ::: "memory")
#define PG8_WAIT_L(n) asm volatile("s_waitcnt lgkmcnt(" #n ")" ::: "memory")
#define PG8_BAR __builtin_amdgcn_s_barrier()
#define PG8_SCHED __builtin_amdgcn_sched_barrier(0)
#define PG8_SETV(v, u) do { _Pragma("unroll") for (int h_ = 0; h_ < 2; ++h_) _Pragma("unroll") for (int i_ = 0; i_ < 2; ++i_) { int R_, C_; stage_rc(tid * 16 + i_ * 8192, R_, C_); \
        const int r_ = h_ * HALF + R_; const long row_ = GATHER ? (long)S.arow(u, r_) : (long)r_; v[h_][i_] = (unsigned)((row_ * lda + C_) * 2); } } while (0)
    Unit cur, nxt; int ui = 0;
    if (!S.next(0, cur)) return;
    f32x4 acc[2][2][4][2];
#pragma unroll
    for (int a = 0; a < 2; ++a)
#pragma unroll
        for (int b = 0; b < 2; ++b)
#pragma unroll
            for (int m = 0; m < 4; ++m)
#pragma unroll
                for (int n = 0; n < 2; ++n) acc[a][b][m][n] = (f32x4){0.f, 0.f, 0.f, 0.f};
    bf16x8 At[4][2], B0[2][2], B1[2][2];
    unsigned vA[2][2], vN[2][2];
    PG8_SETV(vA, cur);
    const size_t tstepA = (size_t)BM * lda * 2;
    const char* cA = (const char*)g.A + (GATHER ? (size_t)0 : (size_t)cur.pm * tstepA); const char* cB = (const char*)g.Bt + (size_t)cur.pn * tstepB;
    PG8_STAGE(PG8_SB(0, 0), cB, voffB2[0]); PG8_STAGE(PG8_SB(0, 1), cB, voffB2[1]); PG8_STAGE(PG8_SA(0, 0), cA, vA[0]); PG8_STAGE(PG8_SA(0, 1), cA, vA[1]);
    if (wr == 1) PG8_BAR;
    PG8_WAIT_V(2); PG8_BAR;
    PG8_STAGE(PG8_SB(1, 0), cB + kstep, voffB2[0]); PG8_STAGE(PG8_SA(1, 0), cA + kstep, vA[0]); PG8_STAGE(PG8_SB(1, 1), cB + kstep, voffB2[1]);
    PG8_WAIT_V(6); PG8_BAR;
    for (;;) {
        const bool has_next = S.next(ui + 1, nxt);
        const char* nA = has_next ? (const char*)g.A + (GATHER ? (size_t)0 : (size_t)nxt.pm * tstepA) : cA; const char* nB = has_next ? (const char*)g.Bt + (size_t)nxt.pn * tstepB : cB;
        if (GATHER) { if (has_next) { PG8_SETV(vN, nxt); } else {
#pragma unroll
            for (int h_ = 0; h_ < 2; ++h_)
#pragma unroll
                for (int i_ = 0; i_ < 2; ++i_) vN[h_][i_] = vA[h_][i_]; } }
#pragma unroll 1
        for (int t = 0; t < nt; t += 2) {
            const bool last = (t == nt - 2);
            const char* a1 = cA + (size_t)(t + 1) * kstep;
            const char* a2 = last ? nA : cA + (size_t)(t + 2) * kstep; const char* b2 = last ? nB : cB + (size_t)(t + 2) * kstep;
            const char* a3 = a2 + kstep; const char* b3 = b2 + kstep;
            unsigned v2[2][2];
#pragma unroll
            for (int h_ = 0; h_ < 2; ++h_)
#pragma unroll
                for (int i_ = 0; i_ < 2; ++i_) v2[h_][i_] = GATHER ? (last ? vN[h_][i_] : vA[h_][i_]) : vA[h_][i_];
            PG8_LDB(B0, 0, 0); PG8_LDB(B1, 0, 1); PG8_SCHED; PG8_LDA(At, 0, 0); PG8_STAGE(PG8_SA(1, 1), a1, vA[1]);
            PG8_WAIT_V(8); PG8_WAIT_L(0); PG8_BAR; PG8_MMA(0, 0, At, B0); PG8_MMA(0, 1, At, B1); PG8_BAR; PG8_SCHED;
            PG8_LDA(At, 0, 1); PG8_STAGE(PG8_SB(0, 0), b2, voffB2[0]); PG8_STAGE(PG8_SB(0, 1), b2, voffB2[1]); PG8_STAGE(PG8_SA(0, 0), a2, v2[0]);
            PG8_WAIT_V(8); PG8_WAIT_L(0); PG8_BAR; PG8_MMA(1, 0, At, B0); PG8_MMA(1, 1, At, B1); PG8_BAR; PG8_SCHED;
            PG8_LDB(B0, 1, 0); PG8_LDB(B1, 1, 1); PG8_SCHED; PG8_LDA(At, 1, 0); PG8_STAGE(PG8_SA(0, 1), a2, v2[1]);
            PG8_WAIT_V(8); PG8_WAIT_L(0); PG8_BAR; PG8_MMA(0, 0, At, B0); PG8_MMA(0, 1, At, B1); PG8_BAR; PG8_SCHED;
            PG8_LDA(At, 1, 1); PG8_STAGE(PG8_SB(1, 0), b3, voffB2[0]); PG8_STAGE(PG8_SB(1, 1), b3, voffB2[1]); PG8_STAGE(PG8_SA(1, 0), a3, v2[0]);
            PG8_WAIT_V(8); PG8_WAIT_L(0); PG8_BAR; PG8_MMA(1, 0, At, B0); PG8_MMA(1, 1, At, B1); PG8_BAR; PG8_SCHED;
        }
        if (wr == 0) PG8_BAR;
        if constexpr (FP8) asm volatile("s_nop 15\n\ts_nop 7" ::: "memory");
        E(acc, cur, wr, wc, fr, fq);
        if (!has_next) break;
#pragma unroll
        for (int a = 0; a < 2; ++a)
#pragma unroll
            for (int b = 0; b < 2; ++b)
#pragma unroll
                for (int m = 0; m < 4; ++m)
#pragma unroll
                    for (int n = 0; n < 2; ++n) acc[a][b][m][n] = (f32x4){0.f, 0.f, 0.f, 0.f};
        cur = nxt; cA = nA; cB = nB; ++ui;
        if (GATHER) {
#pragma unroll
            for (int h_ = 0; h_ < 2; ++h_)
#pragma unroll
                for (int i_ = 0; i_ < 2; ++i_) vA[h_][i_] = vN[h_][i_]; }
        if (wr == 1) PG8_BAR;
    }
    PG8_WAIT_V(0);
    PG8_BAR;
#undef PG8_SA
#undef PG8_SB
#undef PG8_STAGE
#undef PG8_LDA
#undef PG8_LDB
#undef PG8_MMA
#undef PG8_CAT
#undef PG8_WAIT_V
#undef PG8_WAIT_L
#undef PG8_BAR
#undef PG8_SCHED
#undef PG8_SETV
}

typedef const f32x4 (&AccRef)[2][2][4][2];

__device__ __forceinline__ float quad_sum(float s) { s += __shfl_xor(s, 16); s += __shfl_xor(s, 32); return s; }

__device__ __forceinline__ u32x4 ror8x4(u32x4 v) {
    u32x4 r;
#pragma unroll
    for (int i = 0; i < 4; ++i) r[i] = (unsigned)__builtin_amdgcn_update_dpp(0, (int)v[i], 0x128, 0xf, 0xf, false);
    return r;
}
struct EpiZ {
    bf16* Z; unsigned char* KR; float* RSQ; float* RSKV; const float* COS; const float* SIN; unsigned char* CQ8; unsigned char* CKV8;
    __device__ __forceinline__ void operator()(AccRef acc, const Unit& u, int wr, int wc, int fr, int fq) const {
        const int pn = u.pn; const bool lo8 = fr < 8;
#pragma unroll
        for (int ai = 0; ai < 2; ++ai) {
#pragma unroll
          for (int mp = 0; mp < 2; ++mp) {
            f32x4 kcs[4][2], ksn[4][2];
            if (pn == 12 && wc == 2) {
#pragma unroll
                for (int mm = 0; mm < 2; ++mm)
#pragma unroll
                    for (int bj = 0; bj < 2; ++bj) { const int m = 2 * mp + mm, row = u.pm * BM + ai * HALF + wr * 64 + m * 16 + fr, gq = 4 * bj + fq;
                        kcs[m][bj] = *(const f32x4*)(COS + (size_t)row * 32 + 4 * gq); ksn[m][bj] = *(const f32x4*)(SIN + (size_t)row * 32 + 4 * gq); }
            }
#pragma unroll
            for (int m = 2 * mp; m < 2 * mp + 2; ++m) {
                const int row = u.pm * BM + ai * HALF + wr * 64 + m * 16 + fr;
                f32x4 v[2][2]; float ss = 0.f;
                if (pn < 8) {
#pragma unroll
                    for (int bj = 0; bj < 2; ++bj)
#pragma unroll
                        for (int hh = 0; hh < 2; ++hh)
#pragma unroll
                            for (int i = 0; i < 4; ++i) v[bj][hh][i] = __builtin_amdgcn_rcpf(1.f + __builtin_amdgcn_exp2f(acc[ai][bj][m][hh][i] * (-1.4426950408889634f * W8_INV)));
                    const u32x4 w0 = pack8(v[0][0], v[0][1]), w1 = pack8(v[1][0], v[1][1]);
                    const u32x4 rcv = ror8x4(lo8 ? w1 : w0);
                    bf16* zb = Z + (size_t)(lo8 ? row : row - 8) * NZP + pn * BM + wc * 64 + (lo8 ? fq : 4 + fq) * 8;
                    __builtin_nontemporal_store(lo8 ? w0 : rcv, (u32x4*)zb);
                    __builtin_nontemporal_store(lo8 ? rcv : w1, (u32x4*)(zb + (size_t)8 * NZP));
                    continue;
                }
#pragma unroll
                for (int bj = 0; bj < 2; ++bj) {
                    v[bj][0] = acc[ai][bj][m][0] * W8_INV; v[bj][1] = acc[ai][bj][m][1] * W8_INV;
                    ss += (v[bj][0][0] * v[bj][0][0] + v[bj][0][1] * v[bj][0][1]) + (v[bj][0][2] * v[bj][0][2] + v[bj][0][3] * v[bj][0][3])
                        + (v[bj][1][0] * v[bj][1][0] + v[bj][1][1] * v[bj][1][1]) + (v[bj][1][2] * v[bj][1][2] + v[bj][1][3] * v[bj][1][3]);
                }
                if (pn == 12 && wc >= 2) {
                    if (wc == 2) {
#pragma unroll
                        for (int bj = 0; bj < 2; ++bj) { const int gq = 4 * bj + fq;
                            const f32x4 cs = kcs[m][bj], sn = ksn[m][bj];
                            const f32x4 o1 = v[bj][0] * cs - v[bj][1] * sn, o2 = v[bj][1] * cs + v[bj][0] * sn;
                            u32x2 o8 = {cvt4_fp8(o1[0], o1[1], o1[2], o1[3]), cvt4_fp8(o2[0], o2[1], o2[2], o2[3])};
                            *(u32x2*)(KR + (size_t)row * 64 + 8 * gq) = o8; }
                    }
                } else if (pn >= 10) {
                    const bool isq = pn == 10 || (pn == 11 && wc < 2);
                    const int cb = (pn == 10) ? 64 * wc : (pn == 11) ? (wc < 2 ? 256 + 64 * wc : 64 * (wc - 2)) : 128 + 64 * wc;
                    unsigned char* dp = (isq ? CQ8 + (size_t)row * CQP : CKV8 + (size_t)row * KVL) + cb + 8 * fq;
#pragma unroll
                    for (int bj = 0; bj < 2; ++bj) { u32x2 o8 = {cvt4_fp8(v[bj][0][0], v[bj][0][1], v[bj][0][2], v[bj][0][3]), cvt4_fp8(v[bj][1][0], v[bj][1][1], v[bj][1][2], v[bj][1][3])};
                        *(u32x2*)(dp + 32 * bj) = o8;
                        if (pn == 11 && wc < 2) *(u32x2*)(dp + 128 + 32 * bj) = (u32x2){0u, 0u}; }
                } else {
                    const u32x4 w0 = pack8(v[0][0], v[0][1]), w1 = pack8(v[1][0], v[1][1]);
                    const u32x4 rcv = ror8x4(lo8 ? w1 : w0);
                    bf16* zb = Z + (size_t)(lo8 ? row : row - 8) * NZP + pn * BM + wc * 64 + (lo8 ? fq : 4 + fq) * 8;
                    __builtin_nontemporal_store(lo8 ? w0 : rcv, (u32x4*)zb);
                    __builtin_nontemporal_store(lo8 ? rcv : w1, (u32x4*)(zb + (size_t)8 * NZP));
                }
                if (pn >= 10) {
                    const float s = quad_sum(ss);
                    if (fq == 0) {
                        if (pn == 10) RSQ[(size_t)row * 8 + wc] = s;
                        else if (pn == 11) { RSQ[(size_t)row * 8 + 4 + wc] = wc < 2 ? s : 0.f; if (wc >= 2) RSKV[(size_t)row * 8 + wc - 2] = s; }
                        else { if (wc < 2) RSKV[(size_t)row * 8 + 2 + wc] = s; RSKV[(size_t)row * 8 + 4 + wc] = 0.f; }
                    }
                }
            }
          }
        }
    }
};
struct EpiQ {
    unsigned char* Q; const float* RSQ; const float* COS; const float* SIN;
    __device__ __forceinline__ void operator()(AccRef acc, const Unit& u, int wr, int wc, int fr, int fq) const {
        int c0[2], gq[2]; bool rp[2];
#pragma unroll
        for (int bj = 0; bj < 2; ++bj) { c0[bj] = u.pn * BM + bj * HALF + wc * 32 + 8 * fq; const int head = c0[bj] / DQK, within = c0[bj] - head * DQK;
            rp[bj] = within >= QKN; gq[bj] = rp[bj] ? (within - QKN) >> 3 : 0; }
        const int rbj = __builtin_amdgcn_readfirstlane(rp[0] ? 0 : (rp[1] ? 1 : -1));
        const int gqr = rbj == 1 ? gq[1] : gq[0];
#pragma unroll
        for (int ai = 0; ai < 2; ++ai) {
            f32x4 cs[4], sn[4], r0[4], r1[4];
#pragma unroll
            for (int m = 0; m < 4; ++m) { const int row = u.pm * BM + ai * HALF + wr * 64 + m * 16 + fr;
                r0[m] = *(const f32x4*)(RSQ + (size_t)row * 8); r1[m] = *(const f32x4*)(RSQ + (size_t)row * 8 + 4); }
            if (rbj >= 0) {
#pragma unroll
                for (int m = 0; m < 4; ++m) { const int row = u.pm * BM + ai * HALF + wr * 64 + m * 16 + fr;
                    cs[m] = *(const f32x4*)(COS + (size_t)row * 32 + 4 * gqr); sn[m] = *(const f32x4*)(SIN + (size_t)row * 32 + 4 * gqr); }
            }
#pragma unroll
            for (int m = 0; m < 4; ++m) {
                const int row = u.pm * BM + ai * HALF + wr * 64 + m * 16 + fr;
                const float ssq = ((r0[m][0] + r0[m][1]) + (r0[m][2] + r0[m][3])) + ((r1[m][0] + r1[m][1]) + (r1[m][2] + r1[m][3]));
                const float inv = __builtin_amdgcn_rsqf(ssq * (1.f / QL) + EPS) * W8_INV;
#pragma unroll
                for (int bj = 0; bj < 2; ++bj) {
                    f32x4 v0 = acc[ai][bj][m][0] * inv, v1 = acc[ai][bj][m][1] * inv;
                    if (rbj == bj) { const f32x4 o1 = v0 * cs[m] - v1 * sn[m], o2 = v1 * cs[m] + v0 * sn[m]; v0 = o1; v1 = o2; }
                    u32x2 o8 = {cvt4_fp8(v0[0], v0[1], v0[2], v0[3]), cvt4_fp8(v1[0], v1[1], v1[2], v1[3])}; *(u32x2*)(Q + (size_t)row * NQ + c0[bj]) = o8;
                }
            }
        }
    }
};
struct EpiKV {
    unsigned char* KN; unsigned char* VT; const float* RSKV;
    __device__ __forceinline__ void operator()(AccRef acc, const Unit& u, int wr, int wc, int fr, int fq) const {
        const int lane = fq * 16 + fr;
#pragma unroll
        for (int ai = 0; ai < 2; ++ai) {
            f32x4 iv[4];
#pragma unroll
            for (int m = 0; m < 4; ++m) {
                const int row = u.pm * BM + ai * HALF + wr * 64 + m * 16 + fr;
                const f32x4 r0 = *(const f32x4*)(RSKV + (size_t)row * 8), r1 = *(const f32x4*)(RSKV + (size_t)row * 8 + 4);
                const float ssq = ((r0[0] + r0[1]) + (r0[2] + r0[3])) + ((r1[0] + r1[1]) + (r1[2] + r1[3]));
                const float inv = __builtin_amdgcn_rsqf(ssq * (1.f / KVL) + EPS) * W8_INV;
                const size_t o = (size_t)row * 1024 + u.pn * 128 + wc * 32 + 8 * fq;
                { const f32x4 k0 = acc[ai][0][m][0] * inv, k1 = acc[ai][0][m][1] * inv; u32x2 o8 = {cvt4_fp8(k0[0], k0[1], k0[2], k0[3]), cvt4_fp8(k1[0], k1[1], k1[2], k1[3])}; *(u32x2*)(KN + o) = o8; }
#pragma unroll
                for (int r = 0; r < 4; ++r) iv[m][r] = __shfl(inv, (lane & 48) | (4 * fq + r));
            }
            const int tokt = u.pm * 4 + ai * 2 + wr;
            const int bb = tokt >> 8, jt = tokt & 255, pos16 = 32 * (fq & 1) + 16 * (fq >> 1);
#pragma unroll
            for (int n = 0; n < 2; ++n) {
                const int dv = wc * 32 + 8 * (fr >> 2) + 4 * n + (fr & 3);
                unsigned w[4];
#pragma unroll
                for (int m = 0; m < 4; ++m) { const f32x4 v = acc[ai][1][m][n] * iv[m]; w[m] = cvt4_fp8(v[0], v[1], v[2], v[3]); }
                auto ra = __builtin_amdgcn_permlane32_swap(w[0], w[2], false, false); auto rb = __builtin_amdgcn_permlane32_swap(w[1], w[3], false, false);
                u32x4 o16 = {ra[0], ra[1], rb[0], rb[1]};
                *(u32x4*)(VT + ((((size_t)bb * NH + u.pn) * 256 + jt) * 128 + dv) * 64 + pos16) = o16;
            }
        }
    }
};
struct EpiOut {
    bf16* DX; const float* gm;
    __device__ __forceinline__ void operator()(AccRef acc, const Unit& u, int wr, int wc, int fr, int fq) const {
        const bool lo8 = fr < 8;
#pragma unroll
        for (int ai = 0; ai < 2; ++ai)
#pragma unroll
            for (int m = 0; m < 4; ++m) {
                const int row = u.pm * BM + ai * HALF + wr * 64 + m * 16 + fr;
                const int b = row >= SEQ ? 1 : 0;
                u32x4 w[2];
#pragma unroll
                for (int bj = 0; bj < 2; ++bj) {
                    const float* gp = gm + b * 6 * D + u.pn * BM + wc * 64 + bj * 32 + 8 * fq;
                    const f32x4 g0 = *(const f32x4*)gp, g1 = *(const f32x4*)(gp + 4);
                    w[bj] = pack8(g0 * acc[ai][bj][m][0], g1 * acc[ai][bj][m][1]);
                }
                const u32x4 rcv = ror8x4(lo8 ? w[1] : w[0]);
                bf16* zb = DX + (size_t)(lo8 ? row : row - 8) * D + u.pn * BM + wc * 64 + (lo8 ? fq : 4 + fq) * 8;
                __builtin_nontemporal_store(lo8 ? w[0] : rcv, (u32x4*)zb);
                __builtin_nontemporal_store(lo8 ? rcv : w[1], (u32x4*)(zb + (size_t)8 * D));
            }
    }
};
struct EpiGU {
    unsigned char* ACT; const float* bgu;
    __device__ __forceinline__ void operator()(AccRef acc, const Unit& u, int wr, int wc, int fr, int fq) const {
        const int pnl = u.pn & 7, j0 = pnl * 128 + wc * 32 + 8 * fq;
        const float* bp = bgu + (size_t)u.e * 2 * DFF + j0;
        constexpr float CG = -1.702f * 1.4426950408889634f, SG = CG * W8_INV, SL = W8_INV / CG, GMIN = 7.f * CG, LLO = 8.f / CG, LHI = -6.f / CG;
        const f32x4 bg0 = *(const f32x4*)bp * CG, bg1 = *(const f32x4*)(bp + 4) * CG, bl0 = (*(const f32x4*)(bp + DFF) + 1.f) * (1.f / CG), bl1 = (*(const f32x4*)(bp + DFF + 4) + 1.f) * (1.f / CG);
#pragma unroll
        for (int ai = 0; ai < 2; ++ai)
#pragma unroll
            for (int m = 0; m < 4; ++m) {
                const int row = u.pm * BM + ai * HALF + wr * 64 + m * 16 + fr;
                f32x4 a0, a1;
#pragma unroll
                for (int i = 0; i < 4; ++i) {
                    float gp = fmaxf(__builtin_fmaf(acc[ai][0][m][0][i], SG, bg0[i]), GMIN), lp = __builtin_amdgcn_fmed3f(__builtin_fmaf(acc[ai][1][m][0][i], SL, bl0[i]), LLO, LHI);
                    a0[i] = gp * __builtin_amdgcn_rcpf(1.f + __builtin_amdgcn_exp2f(gp)) * lp;
                    gp = fmaxf(__builtin_fmaf(acc[ai][0][m][1][i], SG, bg1[i]), GMIN); lp = __builtin_amdgcn_fmed3f(__builtin_fmaf(acc[ai][1][m][1][i], SL, bl1[i]), LLO, LHI);
                    a1[i] = gp * __builtin_amdgcn_rcpf(1.f + __builtin_amdgcn_exp2f(gp)) * lp;
                }
                u32x2 o = {cvt4_fp8(a0[0], a0[1], a0[2], a0[3]), cvt4_fp8(a1[0], a1[1], a1[2], a1[3])};
                __builtin_nontemporal_store(o, (u32x2*)(ACT + (size_t)row * DFF + j0));
            }
    }
};
struct EpiDown {
    unsigned char* Y; const float* bdn; const int* sdest; const float* sw;
    __device__ __forceinline__ void operator()(AccRef acc, const Unit& u, int wr, int wc, int fr, int fq) const {
        const int pnl = u.pn & 3, c0 = pnl * BM + wc * 64 + 16 * fq;
        const float* bp = bdn + (size_t)u.e * D + c0;
        const f32x4 b00 = *(const f32x4*)bp, b01 = *(const f32x4*)(bp + 4), b10 = *(const f32x4*)(bp + 8), b11 = *(const f32x4*)(bp + 12);
        int dst8[8]; float wt8[8];
#pragma unroll
        for (int q = 0; q < 8; ++q) { const int pos = u.r0 + (q >> 2) * HALF + wr * 64 + (q & 3) * 16 + fr; const int pc = pos < u.cnt ? pos : u.cnt - 1;
            dst8[q] = sdest[(size_t)u.e * T + pc]; wt8[q] = sw[(size_t)u.e * T + pc]; }
#pragma unroll
        for (int ai = 0; ai < 2; ++ai)
#pragma unroll
            for (int m = 0; m < 4; ++m) {
                const int pos = u.r0 + ai * HALF + wr * 64 + m * 16 + fr;
                if (pos < u.cnt) {
                    const int dest = dst8[ai * 4 + m]; const float w = wt8[ai * 4 + m];
                    const f32x4 y00 = (acc[ai][0][m][0] * W8_INV + b00) * w, y01 = (acc[ai][0][m][1] * W8_INV + b01) * w;
                    const f32x4 y10 = (acc[ai][1][m][0] * W8_INV + b10) * w, y11 = (acc[ai][1][m][1] * W8_INV + b11) * w;
                    const u32x4 o = {cvt4_fp8(y00[0], y00[1], y00[2], y00[3]), cvt4_fp8(y01[0], y01[1], y01[2], y01[3]), cvt4_fp8(y10[0], y10[1], y10[2], y10[3]), cvt4_fp8(y11[0], y11[1], y11[2], y11[3])};
                    __builtin_nontemporal_store(o, (u32x4*)(Y + (size_t)dest * D + c0));
                }
            }
    }
};
}

namespace att {
constexpr int KSLOT = 12288, VSLOT = 8192, NSLOT = 3;
constexpr int STG_PITCH = 272, STG_WAVE = 32 * STG_PITCH;
constexpr int LDS_K = 0, LDS_V = NSLOT * KSLOT, LDS_RING_END = LDS_V + NSLOT * VSLOT, LDS_WS = LDS_RING_END > NWAVES * STG_WAVE ? LDS_RING_END : NWAVES * STG_WAVE, LDS_END = LDS_WS + NWAVES * 64 * 4;
static_assert(LDS_END <= RING_BYTES && NWAVES * STG_WAVE <= LDS_WS, "attention LDS map");
constexpr float THR2 = 8.f;

__device__ __forceinline__ int crow(int r, int hi) { return (r & 3) + 8 * (r >> 2) + 4 * hi; }
__device__ __forceinline__ int v_rd_base(int lane) { return ((lane & 3) << 3) | (((lane >> 2) & 3) << 6) | (((lane >> 4) & 1) << 5) | (((lane >> 5) & 1) << 8); }
constexpr int v_rd_off(int d0, int ks, int half) { return d0 * 512 + ks * 4096 + half * 2048; }
__device__ __forceinline__ void glds16(const void* gsrc, unsigned lds_dst) { unsigned keep;
    asm volatile("s_mov_b32 %0, m0\n\ts_mov_b32 m0, %2\n\ts_nop 0\n\tglobal_load_lds_dwordx4 %1, off\n\ts_mov_b32 m0, %0" : "=&s"(keep) : "v"(gsrc), "s"(lds_dst) : "memory"); }

__device__ __forceinline__ void mask_tile(f32x16& p0, f32x16& p1, int dq) {
    const float NEG = -__builtin_inff();
#pragma unroll
    for (int r = 0; r < 16; ++r) {
        const int c = (r & 3) + 8 * (r >> 2);
        if (dq - c < 0) p0[r] = NEG;
        if (dq - c - 32 < 0) p1[r] = NEG;
    }
}
template <int OFF> __device__ __forceinline__ i32x4 ldsr(unsigned a) { i32x4 v; asm volatile("ds_read_b128 %0, %1 offset:%2" : "=v"(v) : "v"(a), "n"(OFF) : "memory"); return v; }
#define LDSW4(a, b, c, d) asm volatile("s_waitcnt lgkmcnt(0)" : "+v"(a), "+v"(b), "+v"(c), "+v"(d) :: "memory")
#define LDSW2(a, b) asm volatile("s_waitcnt lgkmcnt(0)" : "+v"(a), "+v"(b) :: "memory")
#define LDSC2(a, b) asm volatile("s_waitcnt lgkmcnt(2)" : "+v"(a), "+v"(b) :: "memory")
#define CAT8(x, y) __builtin_shufflevector(x, y, 0, 1, 2, 3, 4, 5, 6, 7)
__device__ __forceinline__ void softmax_ref(f32x16& p0, f32x16& p1, bool first, f32x16& negm, float& alpha) {
    float a = fmaxf(fmaxf(p0[0], p0[1]), p1[0]), b = fmaxf(fmaxf(p0[2], p0[3]), p1[1]);
#pragma unroll
    for (int r = 4; r < 16; r += 4) { a = fmaxf(fmaxf(a, p0[r]), p0[r + 1]); b = fmaxf(fmaxf(b, p0[r + 2]), p0[r + 3]); }
#pragma unroll
    for (int r = 2; r < 16; r += 2) { a = fmaxf(a, p1[r]); b = fmaxf(b, p1[r + 1]); }
    float pmax = fmaxf(a, b);
    alpha = 1.f;
    if (__builtin_expect(first || __any(pmax > THR2), 0)) {
        { auto rr = __builtin_amdgcn_permlane32_swap(__float_as_uint(pmax), __float_as_uint(pmax), false, false);
          pmax = fmaxf(__uint_as_float(rr[0]), __uint_as_float(rr[1])); }
        const float d = first ? pmax : fmaxf(pmax, 0.f);
        alpha = __builtin_amdgcn_exp2f(-d);
#pragma unroll
        for (int r = 0; r < 16; ++r) { p0[r] -= d; p1[r] -= d; negm[r] -= d; }
    }
}
__device__ __forceinline__ void exp16(f32x16& p) {
#pragma unroll
    for (int r = 0; r < 16; ++r) p[r] = __builtin_amdgcn_exp2f(p[r]);
}
__device__ __forceinline__ void pack_p(const f32x16& p0, const f32x16& p1, i32x8& pa) {
#pragma unroll
    for (int i = 0; i < 4; ++i) { pa[i] = (int)cvt4_fp8(p0[4 * i], p0[4 * i + 1], p0[4 * i + 2], p0[4 * i + 3]); pa[4 + i] = (int)cvt4_fp8(p1[4 * i], p1[4 * i + 1], p1[4 * i + 2], p1[4 * i + 3]); }
}
__device__ __forceinline__ void qkt8(f32x16& p0, f32x16& p1, const LAS char* Kslot, int r32, int hi, const i32x8* q8, const f32x16& negm) {
    p0 = negm; p1 = negm;
    const int key = (r32 >> 2) & 3;
    const unsigned kA = (unsigned)(uintptr_t)(Kslot + r32 * 64 + (((2 * hi) ^ key) << 4)), kB = (unsigned)(uintptr_t)(Kslot + r32 * 64 + (((2 * hi + 1) ^ key) << 4));
#define MFQ(acc, lo, hi_, j) acc = __builtin_amdgcn_mfma_scale_f32_32x32x64_f8f6f4(CAT8(lo, hi_), q8[j], acc, 0, 0, 0, 0x7f7f7f7f, 0, 0x7c7c7c7c)
    i32x4 a0 = ldsr<0>(kA), a1 = ldsr<0>(kB), b0 = ldsr<2048>(kA), b1 = ldsr<2048>(kB);
    LDSC2(a0, a1); MFQ(p0, a0, a1, 0);
    i32x4 c0 = ldsr<4096>(kA), c1 = ldsr<4096>(kB);
    LDSC2(b0, b1); MFQ(p1, b0, b1, 0);
    i32x4 d0 = ldsr<6144>(kA), d1 = ldsr<6144>(kB);
    LDSC2(c0, c1); MFQ(p0, c0, c1, 1);
    a0 = ldsr<8192>(kA); a1 = ldsr<8192>(kB);
    LDSC2(d0, d1); MFQ(p1, d0, d1, 1);
    b0 = ldsr<10240>(kA); b1 = ldsr<10240>(kB);
    LDSC2(a0, a1); MFQ(p0, a0, a1, 2);
    LDSW2(b0, b1); MFQ(p1, b0, b1, 2);
#undef MFQ
}
__device__ __forceinline__ void pv8(f32x16* o, const LAS char* Vslot, int r32, int hi, const i32x8& pa) {
    const int key = (r32 >> 2) & 3;
    const unsigned vA = (unsigned)(uintptr_t)(Vslot + r32 * 64 + (((2 * hi) ^ key) << 4)), vB = (unsigned)(uintptr_t)(Vslot + r32 * 64 + (((2 * hi + 1) ^ key) << 4));
#define MFV(d, lo, hi_) o[d] = __builtin_amdgcn_mfma_scale_f32_32x32x64_f8f6f4(pa, CAT8(lo, hi_), o[d], 0, 0, 0, 0x7f7f7f7f, 0, 0x7f7f7f7f)
    i32x4 a0 = ldsr<0>(vA), a1 = ldsr<0>(vB), b0 = ldsr<2048>(vA), b1 = ldsr<2048>(vB);
    LDSC2(a0, a1); MFV(0, a0, a1);
    i32x4 c0 = ldsr<4096>(vA), c1 = ldsr<4096>(vB);
    LDSC2(b0, b1); MFV(1, b0, b1);
    i32x4 d0 = ldsr<6144>(vA), d1 = ldsr<6144>(vB);
    LDSC2(c0, c1); MFV(2, c0, c1);
    LDSW2(d0, d1); MFV(3, d0, d1);
#undef MFV
}

struct Tensors { const unsigned char* Q; const unsigned char* KN; const unsigned char* KR; const unsigned char* VT; const bf16* Z; const bf16* PO; bf16* MIX; };

__device__ __forceinline__ void attn_unit(int b, int h, int qb, const Tensors& Tn, LAS char* shm, int tid) {
    const int lane = tid & 63, r32 = lane & 31, hi = lane >> 5; const int wid = __builtin_amdgcn_readfirstlane(tid >> 6);
    const int tok0 = b * SEQ, q0 = qb * 256, NT = 4 * (qb + 1);
    const unsigned lds0 = (unsigned)(uintptr_t)shm;
    LAS float* wsf = (LAS float*)(shm + LDS_WS) + wid * 64;
    const int krow = (wid & 3) * 16 + (lane >> 2), kc = (lane & 3) ^ ((krow >> 2) & 3);
    const unsigned char* ksA = (wid < 4) ? Tn.KN + ((size_t)(tok0 + krow) * NH + h) * 128 + kc * 16
                                         : Tn.KN + ((size_t)(tok0 + krow) * NH + h) * 128 + 64 + kc * 16;
    const unsigned char* ksB = Tn.KR + (size_t)(tok0 + krow) * 64 + kc * 16;
    const int vrow = wid * 16 + (lane >> 2), vc = (lane & 3) ^ ((vrow >> 2) & 3);
    const unsigned char* vsA = Tn.VT + (((size_t)(b * NH + h) * 256) * 128 + vrow) * 64 + vc * 16;
    const bool kx = wid < 4;
#define DMA_TILE(t, slot) do { const size_t ko_ = (size_t)(t) * 64 * (NH * 128), ro_ = (size_t)(t) * 64 * 64, vo_ = (size_t)(t) * 8192; \
        const unsigned kd_ = (unsigned)__builtin_amdgcn_readfirstlane(lds0 + LDS_K + (slot) * KSLOT + wid * 1024), vd_ = (unsigned)__builtin_amdgcn_readfirstlane(lds0 + LDS_V + (slot) * VSLOT + wid * 1024); \
        glds16(ksA + ko_, kd_); if (kx) glds16(ksB + ro_, kd_ + 8192); glds16(vsA + vo_, vd_); } while (0)
#define WAIT_TILE(more_) do { if (more_) { if (kx) asm volatile("s_waitcnt vmcnt(3)" ::: "memory"); else asm volatile("s_waitcnt vmcnt(2)" ::: "memory"); } else asm volatile("s_waitcnt vmcnt(0)" ::: "memory"); } while (0)
    i32x8 q8[3];
    { const unsigned char* qp = Tn.Q + ((size_t)(tok0 + q0 + wid * 32 + r32) * NH + h) * DQK + hi * 32;
#pragma unroll
      for (int j = 0; j < 3; ++j) { const i32x4 x0 = *reinterpret_cast<const i32x4*>(qp + j * 64), x1 = *reinterpret_cast<const i32x4*>(qp + j * 64 + 16); q8[j] = __builtin_shufflevector(x0, x1, 0, 1, 2, 3, 4, 5, 6, 7); } }
#pragma unroll
    for (int j = 0; j < 3; ++j) asm volatile("" : "+v"(q8[j]));
    asm volatile("" ::: "memory");
    DMA_TILE(0, 0); DMA_TILE(1, 1);
    f32x16 o[4], negm = f32x16{}; float l_reg = 0.f;
#pragma unroll
    for (int d = 0; d < 4; ++d) o[d] = f32x16{};
    const int qlo = q0 + wid * 32, qm = qlo + r32 - 4 * hi;
    WAIT_TILE(true); asm volatile("s_barrier" ::: "memory");
    const bool g1 = wid >= 4;
    if (g1) asm volatile("s_barrier" ::: "memory");
    int slot = 0;
    for (int t = 0; t < NT; ++t) {
        const bool more = t + 2 < NT; const int s2 = slot >= 1 ? slot - 1 : 2;
        const int kb = t * 64; const bool act = kb <= qlo + 31;
        f32x16 p0, p1; float alpha = 1.f;
        if (g1 && more) DMA_TILE(t + 2, s2);
        if (act) {
            qkt8(p0, p1, shm + LDS_K + slot * KSLOT, r32, hi, q8, negm);
            if (kb + 63 > qlo) mask_tile(p0, p1, qm - kb);
            softmax_ref(p0, p1, t == 0, negm, alpha);
#pragma unroll
            for (int r = 0; r < 14; ++r) p0[r] = __builtin_amdgcn_exp2f(p0[r]);
        }
        if (g1) WAIT_TILE(more);
        asm volatile("s_waitcnt lgkmcnt(0)\n\ts_barrier" ::: "memory");
        if (!g1 && more) DMA_TILE(t + 2, s2);
        if (act) {
            i32x8 pa;
#pragma unroll
            for (int r = 14; r < 16; ++r) p0[r] = __builtin_amdgcn_exp2f(p0[r]);
            exp16(p1); pack_p(p0, p1, pa);
            { float s0 = p0[0] + p0[1], s1 = p0[2] + p0[3], s2 = p1[0] + p1[1], s3 = p1[2] + p1[3];
#pragma unroll
              for (int r = 4; r < 16; r += 4) { s0 += p0[r] + p0[r + 1]; s1 += p0[r + 2] + p0[r + 3]; s2 += p1[r] + p1[r + 1]; s3 += p1[r + 2] + p1[r + 3]; }
              l_reg = l_reg * alpha + ((s0 + s1) + (s2 + s3)); }
            if (__any(alpha < 1.f)) { if (hi == 0) wsf[r32] = alpha; LDS_WAIT();
#pragma unroll
                for (int d_ = 0; d_ < 4; ++d_)
#pragma unroll
                    for (int r = 0; r < 16; ++r) o[d_][r] *= wsf[crow(r, hi)]; }
            pv8(o, shm + LDS_V + slot * VSLOT, r32, hi, pa);
        }
        if (!g1) WAIT_TILE(more);
        asm volatile("s_waitcnt lgkmcnt(0)\n\ts_barrier" ::: "memory");
        slot = slot == 2 ? 0 : slot + 1;
    }
    if (!g1) asm volatile("s_barrier" ::: "memory");
    asm volatile("s_waitcnt vmcnt(0)" ::: "memory");
#undef DMA_TILE
#undef WAIT_TILE
    { auto rr = __builtin_amdgcn_permlane32_swap(__float_as_uint(l_reg), __float_as_uint(l_reg), false, false); l_reg = __uint_as_float(rr[0]) + __uint_as_float(rr[1]); }
    if (hi == 0) wsf[32 + r32] = l_reg;
    LDS_WAIT();
    float rli[16];
#pragma unroll
    for (int r = 0; r < 16; ++r) rli[r] = __builtin_amdgcn_rcpf(wsf[32 + crow(r, hi)]);
    LAS char* stg = shm + wid * STG_WAVE;
#pragma unroll
    for (int hc = 0; hc < 2; ++hc) {
        u32x4 gaA[4], gbA[4], poA[4];
#pragma unroll
        for (int i = 0; i < 4; ++i) { const int q = lane + 64 * i, row = q >> 3, cc = q & 7; const size_t tok = (size_t)(tok0 + q0 + wid * 32 + row); const int col = h * 128 + hc * 64 + cc * 8;
            gaA[i] = *(const u32x4*)(Tn.Z + tok * NZP + ZC_GA + col); gbA[i] = *(const u32x4*)(Tn.Z + tok * NZP + ZC_GB + col); poA[i] = *(const u32x4*)(Tn.PO + tok * D + col); }
#pragma unroll
        for (int dd = 0; dd < 2; ++dd)
#pragma unroll
            for (int r = 0; r < 16; ++r) *(LAS float*)(stg + crow(r, hi) * STG_PITCH + (dd * 32 + r32) * 4) = o[2 * hc + dd][r] * rli[r];
        LDS_WAIT();
#pragma unroll
        for (int i = 0; i < 4; ++i) {
            const int q = lane + 64 * i, row = q >> 3, cc = q & 7;
            const f32x4 a0 = *(const LAS f32x4*)(stg + row * STG_PITCH + cc * 32), a1 = *(const LAS f32x4*)(stg + row * STG_PITCH + cc * 32 + 16);
            const size_t tok = (size_t)(tok0 + q0 + wid * 32 + row); const int col = h * 128 + hc * 64 + cc * 8;
            const u32x4 ga = gaA[i], gb = gbA[i], po = poA[i];
            f32x4 m0, m1;
            m0[0] = bflo(ga[0]) * a0[0] + bflo(gb[0]) * bflo(po[0]); m0[1] = bfhi(ga[0]) * a0[1] + bfhi(gb[0]) * bfhi(po[0]);
            m0[2] = bflo(ga[1]) * a0[2] + bflo(gb[1]) * bflo(po[1]); m0[3] = bfhi(ga[1]) * a0[3] + bfhi(gb[1]) * bfhi(po[1]);
            m1[0] = bflo(ga[2]) * a1[0] + bflo(gb[2]) * bflo(po[2]); m1[1] = bfhi(ga[2]) * a1[1] + bfhi(gb[2]) * bfhi(po[2]);
            m1[2] = bflo(ga[3]) * a1[2] + bflo(gb[3]) * bflo(po[3]); m1[3] = bfhi(ga[3]) * a1[3] + bfhi(gb[3]) * bfhi(po[3]);
            *(u32x4*)(Tn.MIX + tok * D + col) = pack8(m0, m1);
        }
        LDS_WAIT();
    }
    asm volatile("s_waitcnt vmcnt(0) lgkmcnt(0)\n\ts_barrier" ::: "memory");
}
struct ConvJob { const float* w_gu; const float* w_down; unsigned char* wgu8; unsigned char* wdn8; };
__device__ __forceinline__ unsigned pull(gu32* ctr, volatile LAS unsigned* slot, int tid) {
    if (tid == 0) *slot = __hip_atomic_fetch_add(ctr, 1u, RLX_AGENT);
    __syncthreads();
    const unsigned v = *slot;
    __syncthreads();
    return v;
}
template <class TR>
__device__ __forceinline__ void convert_experts(LAS char* lds, gu32* ctr, volatile LAS unsigned* slot, int tid, const TR& tr) {
    constexpr int NSTRIP_GU = NE * (2 * DFF / 32), NSTRIP_DN = NE * (D / 32), NCHUNK = (NSTRIP_GU + NSTRIP_DN) / NWAVES;
    const int wave = __builtin_amdgcn_readfirstlane(tid >> 6), lane = tid & 63;
    for (;;) {
        const unsigned c = pull(ctr, slot, tid);
        if (c >= (unsigned)NCHUNK) break;
        tr((int)c * NWAVES + wave, lds + wave * 16384, lane);
    }
    __syncthreads();
}
template <class TR>
__device__ __forceinline__ void attn_phase(LAS char* lds, const Tensors& Tn, int vcu, int tid, gu32* qctr, gu32* cctr, const TR& tr) {
    volatile LAS unsigned* slot = (volatile LAS unsigned*)(lds + MISC_OFF) + 16;
    const bool conv_first = (vcu & 15) == 15;
    if (conv_first) convert_experts(lds, cctr, slot, tid, tr);
    const int x0 = (vcu >> 5) & 7;
    for (int dx = 0; dx < 8; ++dx) {
        const int x = (x0 + dx) & 7;
        for (;;) {
            const unsigned u = pull(qctr + x * 16, slot, tid);
            if (u >= 128u) break;
            const int bh = 2 * x + (int)(u & 1u);
            attn_unit(bh >> 3, bh & 7, 63 - (int)(u >> 1), Tn, lds, tid);
        }
    }
    if (!conv_first) convert_experts(lds, cctr, slot, tid, tr);
}
}

struct Args { const void* in[22]; float* out; unsigned char* ws; int ph_lo, ph_hi; };
struct Frame {
    LAS unsigned char* lds; gu32* ctl; unsigned char* ws;
    int tid, lane, wave, vcu, G;
};

__device__ __forceinline__ void ld_row(const float* p, int lane, f32x4 (&v)[4]) {
    const f32x4* q = (const f32x4*)p + lane;
#pragma unroll
    for (int j = 0; j < 4; ++j) v[j] = q[64 * j];
}
__device__ __forceinline__ void add_row_bf16(const bf16* p, int lane, f32x4 (&v)[4]) {
    const u32x2* q = (const u32x2*)p + lane;
#pragma unroll
    for (int j = 0; j < 4; ++j) { const u32x2 w = q[64 * j]; v[j][0] += bflo(w[0]); v[j][1] += bfhi(w[0]); v[j][2] += bflo(w[1]); v[j][3] += bfhi(w[1]); }
}
__device__ __forceinline__ void ld_resid(const void* base, bool is_bf16, int row, int lane, f32x4 (&v)[4]) {
    if (is_bf16) { const u32x2* q = (const u32x2*)((const bf16*)base + (size_t)row * D) + lane;
#pragma unroll
        for (int j = 0; j < 4; ++j) { const u32x2 w = q[64 * j]; v[j] = (f32x4){bflo(w[0]), bfhi(w[0]), bflo(w[1]), bfhi(w[1])}; } }
    else ld_row((const float*)base + (size_t)row * D, lane, v);
}
__device__ __forceinline__ void st_row_bf16(bf16* p, int lane, const f32x4 (&v)[4]) {
    u32x2* q = (u32x2*)p + lane;
#pragma unroll
    for (int j = 0; j < 4; ++j) { u32x2 w = {cvtpk(v[j][0], v[j][1]), cvtpk(v[j][2], v[j][3])}; q[64 * j] = w; }
}
__device__ __forceinline__ void st_row_fp8(unsigned char* p, int lane, const f32x4 (&v)[4]) {
    unsigned* q = (unsigned*)p + lane;
#pragma unroll
    for (int j = 0; j < 4; ++j) q[64 * j] = cvt4_fp8(v[j][0], v[j][1], v[j][2], v[j][3]);
}
__device__ __forceinline__ float row_ssq(const f32x4 (&v)[4]) {
    float s = 0.f;
#pragma unroll
    for (int j = 0; j < 4; ++j) s += (v[j][0] * v[j][0] + v[j][1] * v[j][1]) + (v[j][2] * v[j][2] + v[j][3] * v[j][3]);
    return wave_sum(s);
}
__device__ __forceinline__ void adaln_row(const f32x4 (&x)[4], const float* g, const float* sc, const float* sh, int lane, f32x4 (&hout)[4]) {
    const float inv = __builtin_amdgcn_rsqf(row_ssq(x) * (1.f / D) + EPS);
    f32x4 gv[4], scv[4], shv[4]; ld_row(g, lane, gv); ld_row(sc, lane, scv); ld_row(sh, lane, shv);
#pragma unroll
    for (int j = 0; j < 4; ++j) hout[j] = (x[j] * inv) * gv[j] * (scv[j] + 1.f) + shv[j];
}

__device__ __forceinline__ void adaln_vecs(const float* g, const float* sc, const float* sh, int lane, f32x4 (&av)[4], f32x4 (&sv)[4]) {
    f32x4 gv[4], scv[4]; ld_row(g, lane, gv); ld_row(sc, lane, scv); ld_row(sh, lane, sv);
#pragma unroll
    for (int j = 0; j < 4; ++j) av[j] = gv[j] * (scv[j] + 1.f);
}
__device__ __forceinline__ void adaln_apply(const f32x4 (&x)[4], const f32x4 (&av)[4], const f32x4 (&sv)[4], f32x4 (&hout)[4]) {
    const float inv = __builtin_amdgcn_rsqf(row_ssq(x) * (1.f / D) + EPS);
#pragma unroll
    for (int j = 0; j < 4; ++j) hout[j] = (x[j] * inv) * av[j] + sv[j];
}
template <class RowMap>
__device__ __forceinline__ void tr_item(const float* W, int K, int N, bf16* WT, const RowMap& rm, const float* ks, const float* ns, float cs, LAS float* scr, int item, int lane) {
    const int nblk = N / 32, kb = item / nblk, nb = item % nblk, k0 = 64 * kb, n0 = 32 * nb;
    const float nsv = ns ? ns[n0 + (lane & 31)] * cs : cs;
#pragma unroll 8
    for (int i = 0; i < 32; ++i) { const int kk = 2 * i + (lane >> 5); float v = W[(size_t)(k0 + kk) * N + n0 + (lane & 31)] * nsv; if (ks) v *= ks[k0 + kk]; scr[kk * 33 + (lane & 31)] = v; }
    LDS_WAIT(); asm volatile("" ::: "memory");
    const int c = lane & 7;
#pragma unroll
    for (int j = 0; j < 4; ++j) { const int n = (lane >> 3) + 8 * j; const LAS float* s = scr + (8 * c) * 33 + n;
        u32x4 o; o.x = cvtpk(s[0 * 33], s[1 * 33]); o.y = cvtpk(s[2 * 33], s[3 * 33]); o.z = cvtpk(s[4 * 33], s[5 * 33]); o.w = cvtpk(s[6 * 33], s[7 * 33]);
        *(u32x4*)(WT + (size_t)rm(n0 + n) * K + k0 + 8 * c) = o; }
    LDS_WAIT(); asm volatile("" ::: "memory");
}
template <class RowMap>
__device__ __forceinline__ void tr_item8(const float* W, int K, int N, unsigned char* WT, const RowMap& rm, float cs, LAS float* scr, int item, int lane, int ldk = 0, const float* ks = nullptr) {
    if (ldk == 0) ldk = K;
    const int nblk = N / 32, kb = item / nblk, nb = item % nblk, k0 = 64 * kb, n0 = 32 * nb;
#pragma unroll 16
    for (int i = 0; i < 32; ++i) { const int kk = 2 * i + (lane >> 5); float v = W[(size_t)(k0 + kk) * N + n0 + (lane & 31)] * cs; if (ks) v *= ks[k0 + kk]; scr[kk * 33 + (lane & 31)] = v; }
    LDS_WAIT(); asm volatile("" ::: "memory");
#pragma unroll
    for (int j = 0; j < 2; ++j) { const int pr = lane + 64 * j, n = pr >> 2, c = pr & 3; const LAS float* s = scr + (16 * c) * 33 + n;
        u32x4 o; o.x = cvt4_fp8(s[0 * 33], s[1 * 33], s[2 * 33], s[3 * 33]); o.y = cvt4_fp8(s[4 * 33], s[5 * 33], s[6 * 33], s[7 * 33]);
        o.z = cvt4_fp8(s[8 * 33], s[9 * 33], s[10 * 33], s[11 * 33]); o.w = cvt4_fp8(s[12 * 33], s[13 * 33], s[14 * 33], s[15 * 33]);
        *(u32x4*)(WT + (size_t)rm(n0 + n) * ldk + k0 + 16 * c) = o; }
    LDS_WAIT(); asm volatile("" ::: "memory");
}
template <class RowMap>
__device__ __forceinline__ void tr_strip8(const float* W, int K, int N, unsigned char* WT, const RowMap& rm, float cs, LAS char* scrb, int nb, int lane) {
    const int n0 = 32 * nb, nkb = K / 64, h = lane >> 5, n = lane & 31;
    const float* src = W + (size_t)(32 * h) * N + n0 + n;
    float cur[32], nxt[32];
#pragma unroll
    for (int i = 0; i < 32; ++i) cur[i] = src[(size_t)i * N];
#pragma unroll 1
    for (int kb2 = 0; kb2 < nkb; kb2 += 2) {
#pragma unroll
        for (int par = 0; par < 2; ++par) {
            const int k0 = 64 * (kb2 + par), kn = kb2 + par + 1 < nkb ? k0 + 64 : k0;
#pragma unroll
            for (int i = 0; i < 32; ++i) nxt[i] = src[(size_t)(kn + i) * N];
            u32x4 w0, w1;
            w0.x = cvt4_fp8(cur[0] * cs, cur[1] * cs, cur[2] * cs, cur[3] * cs);     w0.y = cvt4_fp8(cur[4] * cs, cur[5] * cs, cur[6] * cs, cur[7] * cs);
            w0.z = cvt4_fp8(cur[8] * cs, cur[9] * cs, cur[10] * cs, cur[11] * cs);   w0.w = cvt4_fp8(cur[12] * cs, cur[13] * cs, cur[14] * cs, cur[15] * cs);
            w1.x = cvt4_fp8(cur[16] * cs, cur[17] * cs, cur[18] * cs, cur[19] * cs); w1.y = cvt4_fp8(cur[20] * cs, cur[21] * cs, cur[22] * cs, cur[23] * cs);
            w1.z = cvt4_fp8(cur[24] * cs, cur[25] * cs, cur[26] * cs, cur[27] * cs); w1.w = cvt4_fp8(cur[28] * cs, cur[29] * cs, cur[30] * cs, cur[31] * cs);
            LAS char* p = scrb + n * 144 + par * 64 + 32 * h;
            *(LAS u32x4*)p = w0; *(LAS u32x4*)(p + 16) = w1;
#pragma unroll
            for (int i = 0; i < 32; ++i) cur[i] = nxt[i];
        }
        LDS_WAIT(); asm volatile("" ::: "memory");
#pragma unroll
        for (int j = 0; j < 4; ++j) { const int q = lane + 64 * j, row = q >> 3, c = q & 7;
            const u32x4 o = *(const LAS u32x4*)(scrb + row * 144 + c * 16);
            *(u32x4*)(WT + (size_t)rm(n0 + row) * K + 64 * kb2 + 16 * c) = o; }
        LDS_WAIT(); asm volatile("" ::: "memory");
    }
}
__device__ __forceinline__ int rope_pos(int d) { return d < 32 ? 8 * (d >> 2) + (d & 3) : 8 * ((d - 32) >> 2) + 4 + (d & 3); }
struct MapId { __device__ __forceinline__ int operator()(int n) const { return n; } };
struct MapWin { __device__ __forceinline__ int operator()(int n) const {
    if (n < 384) return ZC_CQ + n; if (n < 640) return ZC_CKV + (n - 384); if (n < 704) return ZC_KR + rope_pos(n - 640);
    if (n < 1216) return ZC_POOL + (n - 704); if (n < 2240) return ZC_GA + (n - 1216); return ZC_GB + (n - 2240); } };
struct MapUq { __device__ __forceinline__ int operator()(int n) const { const int head = n / DQK, wi = n - head * DQK; return wi < QKN ? n : head * DQK + QKN + rope_pos(wi - QKN); } };
struct MapGu { __device__ __forceinline__ int operator()(int n) const { const int which = n >> 10, j = n & 1023; return (j >> 7) * 256 + which * 128 + (j & 127); } };

__device__ __forceinline__ void prologue(Frame& F) {
    typedef __attribute__((address_space(4))) const Args* KA; KA a_ = (KA)__builtin_amdgcn_kernarg_segment_ptr(); asm volatile("" : "+s"(a_));
#define a (*a_)
    LAS float* scr = (LAS float*)(F.lds + F.wave * 16384);
    const int gw = F.vcu * NWAVES + F.wave, NGW = F.G * NWAVES, lane = F.lane;
    const float* c_in = (const float*)a.in[1]; const int* pos_in = (const int*)a.in[2];
    const float* ada_w = (const float*)a.in[3]; const float* ada_b = (const float*)a.in[4];
    const float* w_in = (const float*)a.in[7]; const float* q_norm = (const float*)a.in[8]; const float* w_uq = (const float*)a.in[9];
    const float* kv_norm = (const float*)a.in[10]; const float* w_ukv = (const float*)a.in[11]; const float* w_pool = (const float*)a.in[12];
    const float* pool_scale = (const float*)a.in[13]; const float* w_out = (const float*)a.in[14]; const float* w_router = (const float*)a.in[15];
    const float* w_gu = (const float*)a.in[17]; const float* w_down = (const float*)a.in[19];
    unsigned char* ws = F.ws;
    constexpr int I_MOD = DEPTH * (6 * D / 64);
    constexpr int I_WIN = (D / 64) * (NZ / 32), I_UQ = (QL / 64) * (NQ / 32), I_UKV = (KVL / 64) * (NKV / 32), I_POOL = 4 * (128 / 64) * (256 / 32), I_OUT = (D / 64) * (D / 32);
    constexpr int I_SMALL = DEPTH * (I_WIN + I_UQ + I_UKV + I_POOL + I_OUT);
    constexpr int I_GU1 = (D / 64) * (2 * DFF / 32), I_DN1 = (DFF / 64) * (D / 32);
    constexpr int I_GU = DEPTH * NE * I_GU1, I_DN = DEPTH * NE * I_DN1;
    constexpr int S_GU = I_GU / (D / 64), S_DN = I_DN / (DFF / 64);
    constexpr int NITEMS = I_MOD + I_SMALL;
    for (int item = F.vcu; item < I_MOD; item += F.G) {
        const int l = item / (6 * D / 64), n = (item % (6 * D / 64)) * 64 + lane, kbase = 128 * F.wave;
        const float* wp = ada_w + (size_t)l * D * 6 * D + (size_t)kbase * 6 * D + n; float a0 = 0.f, a1 = 0.f;
#pragma unroll
        for (int i = 0; i < 2; ++i) { const float c0 = c_in[kbase + 64 * i + lane], c1 = c_in[D + kbase + 64 * i + lane]; scr[64 * i + lane] = c0 * sigmoid_f(c0); scr[128 + 64 * i + lane] = c1 * sigmoid_f(c1); }
        LDS_WAIT(); asm volatile("" ::: "memory");
        for (int k0 = 0; k0 < 128; k0 += 32) { float w[32];
#pragma unroll
            for (int i = 0; i < 32; ++i) w[i] = wp[(size_t)(k0 + i) * 6 * D];
#pragma unroll
            for (int i = 0; i < 32; ++i) { a0 += w[i] * scr[k0 + i]; a1 += w[i] * scr[128 + k0 + i]; } }
        scr[1024 + lane] = a0; scr[1088 + lane] = a1;
        __syncthreads();
        if (F.wave == 0) {
            float s0 = 0.f, s1 = 0.f;
#pragma unroll
            for (int w = 0; w < NWAVES; ++w) { const LAS float* pw = (const LAS float*)(F.lds + w * 16384); s0 += pw[1024 + lane]; s1 += pw[1088 + lane]; }
            float* mod = (float*)(ws + WS_MOD) + (size_t)l * 2 * 6 * D; const float bb = ada_b[(size_t)l * 6 * D + n];
            mod[n] = s0 + bb; mod[6 * D + n] = s1 + bb; }
        __syncthreads();
    }
    for (int it = gw; it < I_SMALL; it += NGW) {
        int r = it;
        {
            const int l = r / (I_SMALL / DEPTH); r %= (I_SMALL / DEPTH);
            if (r < I_WIN) { tr_item8(w_in + (size_t)l * D * NZ, D, NZ, ws + WS_WIN + (size_t)l * NZP * D, MapWin(), W8_SCALE, scr, r, lane); continue; } r -= I_WIN;
            if (r < I_UQ) { tr_item8(w_uq + (size_t)l * QL * NQ, QL, NQ, ws + WS_WUQ + (size_t)l * NQ * CQP, MapUq(), QSCALE * W8_SCALE, scr, r, lane, CQP, q_norm + l * QL); continue; } r -= I_UQ;
            if (r < I_UKV) { tr_item8(w_ukv + (size_t)l * KVL * NKV, KVL, NKV, ws + WS_WUKV + (size_t)l * NKV * KVL, MapId(), W8_SCALE, scr, r, lane, KVL, kv_norm + l * KVL); continue; } r -= I_UKV;
            if (r < I_POOL) { const int gg = r / (I_POOL / 4), rr = r % (I_POOL / 4);
                tr_item(w_pool + ((size_t)l * 4 + gg) * 128 * 256, 128, 256, (bf16*)(ws + WS_WPOOL) + ((size_t)l * 4 + gg) * 256 * 128, MapId(), nullptr, pool_scale + ((size_t)l * 4 + gg) * 256, 1.f, scr, rr, lane); continue; } r -= I_POOL;
            tr_item(w_out + (size_t)l * D * D, D, D, (bf16*)(ws + WS_WOUT) + (size_t)l * D * D, MapId(), nullptr, nullptr, 1.f, scr, r, lane); continue; }
    }
    const int gt = F.vcu * NTHREADS + F.tid, NGT = F.G * NTHREADS;
    for (int i = gt; i < DEPTH * 64 * D / 16; i += NGT) { const int l = i / (64 * D / 16), rr = i % (64 * D / 16);
        *(u32x4*)(ws + WS_WIN + ((size_t)l * NZP + NZ) * D + (size_t)rr * 16) = (u32x4){0u, 0u, 0u, 0u}; }
    for (int i = gt; i < DEPTH * NQ * 8; i += NGT) { const int rowi = i >> 3, ch = i & 7;
        *(u32x4*)(ws + WS_WUQ + (size_t)rowi * CQP + QL + ch * 16) = (u32x4){0u, 0u, 0u, 0u}; }
    for (int i = gt; i < DEPTH * D * NE; i += NGT) { const int l = i / (D * NE), rr = i % (D * NE), k = rr / NE, e = rr % NE;
        const float w = w_router[i]; const unsigned short hb = f2bf(w); const unsigned short lb = f2bf(w - bf2f(hb));
        bf16* wr = (bf16*)(ws + WS_WR) + (size_t)l * 64 * D; wr[(size_t)e * D + k] = hb; wr[(size_t)(32 + e) * D + k] = lb; }
    for (int i = gt; i < T * 32; i += NGT) { const int t = i >> 5, f = i & 31;
        const float inv_freq = exp2f(-(float)f * 0.41524101186092029f);
        const float ang = (float)pos_in[t] * inv_freq;
        const double rev = (double)ang * 0.15915494309189535; const float fr = (float)(rev - floor(rev));
        ((float*)(ws + WS_COS))[i] = __builtin_amdgcn_cosf(fr); ((float*)(ws + WS_SIN))[i] = __builtin_amdgcn_sinf(fr); }
#undef a
}

__device__ __forceinline__ void norm1_phase(Frame& F, const float* x, const float* g, const float* mod  , unsigned char* H) {
    const int gw = F.vcu * NWAVES + F.wave, NGW = F.G * NWAVES, lane = F.lane;
    f32x4 av[4], sv[4], xn[4]; int bcur = -1;
    if (gw < T) ld_row(x + (size_t)gw * D, lane, xn);
    for (int row = gw; row < T; row += NGW) {
        const int b = row >= SEQ ? 1 : 0;
        f32x4 xv[4], hv[4];
#pragma unroll
        for (int j = 0; j < 4; ++j) xv[j] = xn[j];
        if (row + NGW < T) ld_row(x + (size_t)(row + NGW) * D, lane, xn);
        if (b != bcur) { adaln_vecs(g, mod + b * 6 * D + D, mod + b * 6 * D, lane, av, sv); bcur = b; }
        adaln_apply(xv, av, sv, hv);
        st_row_fp8(H + (size_t)row * D, lane, hv);
    }
}

__device__ __forceinline__ void pool_phase(Frame& F, const bf16* Z, const bf16* Wp  , bf16* PO) {
    constexpr int PITCH = 272;
    LAS char* Pl = (LAS char*)F.lds;
    LAS char* Bl = (LAS char*)F.lds + 34816;
    const int tid = F.tid, lane = F.lane, wid = F.wave, fr = lane & 15, fq = lane >> 4;
    const int g = F.vcu & 3, w = 2 << g, nstr = F.G >> 2;
    for (int i = tid; i < 256 * 16; i += NTHREADS) { const int n = i >> 4, ch = i & 15;
        *(LAS u32x4*)(Bl + n * PITCH + ch * 16) = *(const u32x4*)(Wp + ((size_t)g * 256 + n) * 128 + ch * 8); }
    for (int rt = F.vcu >> 2; rt < T / 128; rt += nstr) {
        const int row0 = rt * 128, s0 = row0 & (SEQ - 1);
        { const int cp = tid & 63, rc = tid >> 6;
          unsigned u[31];
          const bf16* zp = Z + (size_t)(row0 + rc * 16 - 15) * NZP + ZC_POOL + g * 128 + cp * 2;
#pragma unroll
          for (int j = 0; j < 31; ++j) u[j] = (s0 + rc * 16 - 15 + j >= 0) ? *(const unsigned*)(zp + (size_t)j * NZP) : 0u;
          float sa = 0.f, sb = 0.f;
#pragma unroll
          for (int j = 1; j < 16; ++j) { if (j < w) { sa += bflo(u[15 - j]); sb += bfhi(u[15 - j]); } }
#pragma unroll
          for (int i = 0; i < 16; ++i) { const int r = rc * 16 + i; const float ua = bflo(u[15 + i]), ub = bfhi(u[15 + i]);
              sa += ua; sb += ub;
              const int pos = s0 + r; const float rcnt = __builtin_amdgcn_rcpf((float)(pos + 1 < w ? pos + 1 : w));
              *(LAS unsigned*)(Pl + r * PITCH + cp * 4) = cvtpk(sa * rcnt - ua, sb * rcnt - ub);
              const unsigned ud = (g == 0) ? u[15 + i - 1] : (g == 1) ? u[15 + i - 3] : (g == 2) ? u[15 + i - 7] : u[i];
              sa -= bflo(ud); sb -= bfhi(ud); } }
        __syncthreads();
        f32x4 acc[16];
#pragma unroll
        for (int n = 0; n < 16; ++n) acc[n] = (f32x4){0.f, 0.f, 0.f, 0.f};
#pragma unroll
        for (int ks = 0; ks < 4; ++ks) {
            const bf16x8 af = *(const LAS bf16x8*)(Pl + (wid * 16 + fr) * PITCH + ks * 64 + fq * 16);
#pragma unroll
            for (int n = 0; n < 16; ++n) { const bf16x8 bfr = *(const LAS bf16x8*)(Bl + (n * 16 + fr) * PITCH + ks * 64 + fq * 16);
                acc[n] = __builtin_amdgcn_mfma_f32_16x16x32_bf16(bfr, af, acc[n], 0, 0, 0); }
        }
        { bf16* op = PO + (size_t)(row0 + wid * 16 + fr) * D + g * 256 + 4 * fq;
#pragma unroll
          for (int n = 0; n < 16; ++n) { u32x2 o = {cvtpk(acc[n][0], acc[n][1]), cvtpk(acc[n][2], acc[n][3])}; *(u32x2*)(op + n * 16) = o; } }
        __syncthreads();
    }
}

__device__ __forceinline__ void router_phase(Frame& F, const void* X1, bool xbf, const bf16* DX, const float* g, const float* mod, const bf16* Wr  , const float* brt, bf16* H, unsigned char* H8,
                                             gu32* cntw  , int* sdest, float* sw) {
    LAS float* part = (LAS float*)F.lds;
    LAS int* hist = (LAS int*)(F.lds + 16384);
    LAS int* base = (LAS int*)(F.lds + 16384 + 128);
    const int lane = F.lane, wid = F.wave, r32 = lane & 31, hi = lane >> 5;
    for (int blk = F.vcu; blk < T / 128; blk += F.G) {
        if (F.tid < 32) hist[F.tid] = 0;
        f32x4 av[4], sv[4], xn[4]; u32x2 dn[4];
        { const int b = (blk * 128) >= SEQ ? 1 : 0; adaln_vecs(g, mod + b * 6 * D + 4 * D, mod + b * 6 * D + 3 * D, lane, av, sv); }
        { const int row = blk * 128 + wid * 16; ld_resid(X1, xbf, row, lane, xn); const u32x2* dp = (const u32x2*)(DX + (size_t)row * D) + lane;
#pragma unroll
          for (int j = 0; j < 4; ++j) dn[j] = dp[64 * j]; }
        for (int i = 0; i < 16; ++i) {
            const int row = blk * 128 + wid * 16 + i;
            f32x4 xv[4], hv[4];
#pragma unroll
            for (int j = 0; j < 4; ++j) xv[j] = xn[j] + (f32x4){bflo(dn[j][0]), bfhi(dn[j][0]), bflo(dn[j][1]), bfhi(dn[j][1])};
            if (i + 1 < 16) { ld_resid(X1, xbf, row + 1, lane, xn); const u32x2* dp = (const u32x2*)(DX + (size_t)(row + 1) * D) + lane;
#pragma unroll
                for (int j = 0; j < 4; ++j) dn[j] = dp[64 * j]; }
            adaln_apply(xv, av, sv, hv);
            st_row_bf16(H + (size_t)row * D, lane, hv);
            { unsigned* q8 = (unsigned*)(H8 + (size_t)row * D) + lane;
#pragma unroll
              for (int j = 0; j < 4; ++j) q8[64 * j] = cvt4_fp8(hv[j][0], hv[j][1], hv[j][2], hv[j][3]); }
        }
        VM_WAIT(); __syncthreads();
        f32x16 lg = f32x16{};
        { const int wq = wid & 3; const bf16* wp = Wr + (size_t)((wid >> 2) * 32 + r32) * D + hi * 8; const bf16* hp = H + (size_t)(blk * 128 + wq * 32 + r32) * D + hi * 8;
#pragma unroll 8
          for (int kk = 0; kk < 64; ++kk) { const bf16x8 af = *reinterpret_cast<const bf16x8*>(wp + kk * 16), bfr = *reinterpret_cast<const bf16x8*>(hp + kk * 16);
              lg = __builtin_amdgcn_mfma_f32_32x32x16_bf16(af, bfr, lg, 0, 0, 0); } }
        if (wid >= 4) {
#pragma unroll
            for (int r = 0; r < 16; ++r) part[((wid & 3) * 16 + r) * 64 + lane] = lg[r]; }
        __syncthreads();
        if (wid < 4) {
            float v[32];
#pragma unroll
            for (int r = 0; r < 16; ++r) { const float s = lg[r] + part[(wid * 16 + r) * 64 + lane];
                auto rr = __builtin_amdgcn_permlane32_swap(__float_as_uint(s), __float_as_uint(s), false, false);
                const int e0 = (r & 3) + 8 * (r >> 2);
                v[e0] = __uint_as_float(rr[0]) + brt[e0]; v[e0 + 4] = __uint_as_float(rr[1]) + brt[e0 + 4]; }
            float tv[4]; int te[4];
#pragma unroll
            for (int k = 0; k < 4; ++k) { float best = v[0]; int bi = 0;
#pragma unroll
                for (int e = 1; e < 32; ++e) { if (v[e] > best) { best = v[e]; bi = e; } }
                tv[k] = best; te[k] = bi;
#pragma unroll
                for (int e = 0; e < 32; ++e) v[e] = (e == bi) ? -__builtin_inff() : v[e]; }
            float ex[4], den = 0.f;
#pragma unroll
            for (int k = 0; k < 4; ++k) { ex[k] = __expf(tv[k] - tv[0]); den += ex[k]; }
            const float rden = 1.f / den;
            int lr[4];
            if (hi == 0) {
#pragma unroll
                for (int k = 0; k < 4; ++k) lr[k] = __hip_atomic_fetch_add(&hist[te[k]], 1, __ATOMIC_RELAXED, __HIP_MEMORY_SCOPE_WORKGROUP); }
            __builtin_amdgcn_s_waitcnt(0);
            asm volatile("s_barrier" ::: "memory");
            if (F.tid < 32) base[F.tid] = (int)__hip_atomic_fetch_add(cntw + 64 * F.tid, (unsigned)hist[F.tid], RLX_AGENT);
            __builtin_amdgcn_s_waitcnt(0);
            asm volatile("s_barrier" ::: "memory");
            if (hi == 0) { const int tok = blk * 128 + wid * 32 + r32;
#pragma unroll
                for (int k = 0; k < 4; ++k) { const int pos = base[te[k]] + lr[k]; sdest[(size_t)te[k] * T + pos] = tok * 4 + k; sw[(size_t)te[k] * T + pos] = ex[k] * rden; } }
        } else {
            asm volatile("s_barrier" ::: "memory");
            asm volatile("s_barrier" ::: "memory");
        }
        __syncthreads();
    }
}

__device__ __forceinline__ int moe_tables(Frame& F, gu32* cntw) {
    LAS int* cnt = (LAS int*)(F.lds + TAB_OFF); LAS int* tstart = cnt + 32; LAS int* tinfo = tstart + 36;
    if (F.tid < 32) cnt[F.tid] = (int)__hip_atomic_load(cntw + 64 * F.tid, RLX_AGENT);
    __syncthreads();
    if (F.tid == 0) { int s = 0; for (int e = 0; e < 32; ++e) { tstart[e] = s; s += (cnt[e] + 255) >> 8; } tstart[32] = s; }
    __syncthreads();
    const int ntr = tstart[32];
    for (int gi = F.tid; gi < ntr; gi += NTHREADS) { int e = 0;
        for (int j = 1; j < 32; ++j) e += (tstart[j] <= gi) ? 1 : 0;
        tinfo[gi] = (e << 16) | (gi - tstart[e]); }
    __syncthreads();
    return ntr;
}

__device__ __forceinline__ void combine_phase(Frame& F, const void* X1, bool xbf, const bf16* DX, const unsigned char* Y, const float* mod, bf16* X2, bool last_layer,
                                              const float* gnext, const float* modnext, unsigned char* H, const float* gfinal, float* out) {
    const int gw = F.vcu * NWAVES + F.wave, NGW = F.G * NWAVES, lane = F.lane;
    for (int row = gw; row < T; row += NGW) {
        const int b = row >= SEQ ? 1 : 0;
        f32x4 xv[4], gf[4], ys[4]; ld_resid(X1, xbf, row, lane, xv); add_row_bf16(DX + (size_t)row * D, lane, xv); ld_row(mod + b * 6 * D + 5 * D, lane, gf);
#pragma unroll
        for (int j = 0; j < 4; ++j) ys[j] = (f32x4){0.f, 0.f, 0.f, 0.f};
#pragma unroll
        for (int k = 0; k < 4; ++k) { const unsigned* yp = (const unsigned*)(Y + ((size_t)row * 4 + k) * D) + lane;
#pragma unroll
            for (int j = 0; j < 4; ++j) { const int w = (int)yp[64 * j]; const f32x2 lo = __builtin_amdgcn_cvt_pk_f32_fp8(w, false), hi2 = __builtin_amdgcn_cvt_pk_f32_fp8(w, true);
                ys[j][0] += lo[0]; ys[j][1] += lo[1]; ys[j][2] += hi2[0]; ys[j][3] += hi2[1]; } }
#pragma unroll
        for (int j = 0; j < 4; ++j) xv[j] = xv[j] + gf[j] * ys[j];
        if (!last_layer) {
            st_row_bf16(X2 + (size_t)row * D, lane, xv);
            f32x4 hv[4]; adaln_row(xv, gnext, modnext + b * 6 * D + D, modnext + b * 6 * D, lane, hv);
            st_row_fp8(H + (size_t)row * D, lane, hv);
        } else {
            const float inv = __builtin_amdgcn_rsqf(row_ssq(xv) * (1.f / D) + EPS);
            f32x4 gv[4]; ld_row(gfinal, lane, gv);
            f32x4* oo = (f32x4*)(out + (size_t)row * D) + lane;
#pragma unroll
            for (int j = 0; j < 4; ++j) oo[64 * j] = (xv[j] * inv) * gv[j];
        }
    }
}

typedef __attribute__((address_space(4))) const Args* KArgs;
__device__ __forceinline__ KArgs kargs() { KArgs p = (KArgs)__builtin_amdgcn_kernarg_segment_ptr(); asm volatile("" : "+s"(p)); return p; }
__device__ __forceinline__ Frame make_frame(unsigned char* lds_raw) {
    Frame F; KArgs ap = kargs();
    int tid = threadIdx.x; asm volatile("" : "+v"(tid));
    F.lds = (LAS unsigned char*)lds_raw; F.ws = ap->ws; F.ctl = (gu32*)(F.ws + WS_CTL);
    F.tid = tid; F.lane = tid & 63; F.wave = __builtin_amdgcn_readfirstlane(tid >> 6);
    F.G = gridDim.x; { const int bx = blockIdx.x; F.vcu = (F.G % 8 == 0) ? (bx % 8) * (F.G / 8) + bx / 8 : bx; }
    return F;
}
#define INP(i) ((const float*)ap->in[i])
__global__ void __launch_bounds__(NTHREADS, 2) fwd_kernel(Args args) {
    extern __shared__ __attribute__((aligned(16))) unsigned char lds_raw[];
    volatile LAS unsigned* MISC = (volatile LAS unsigned*)((LAS unsigned char*)lds_raw + MISC_OFF);
    if (threadIdx.x < 64) MISC[threadIdx.x] = 0u;
    __syncthreads();
    XcdBarrier bar; bar.bar = (unsigned*)(args.ws + WS_CTL) + CW_BAR; bar.x = 0; bar.st = nullptr;
    if (N_LAUNCHES == 1) bar = xcd_barrier_post((unsigned*)(args.ws + WS_CTL) + CW_BAR, MISC + 8);
    const int lo = args.ph_lo, hi = args.ph_hi;
#define IN(k) (lo <= (k) && (k) < hi)
#define SEAM(k) do { if (IN(k) && IN((k) + 1)) { XcdBarrier b2_ = bar; asm volatile("" : "+s"(b2_.bar)); xcd_barrier(b2_); } } while (0)

    if (IN(0)) REP(8) { Frame F = make_frame(lds_raw); prologue(F); }
    SEAM(0);
    if (IN(1)) REP(9) { Frame F = make_frame(lds_raw); KArgs ap = kargs(); norm1_phase(F, INP(0), INP(5), (const float*)(F.ws + WS_MOD), F.ws + WS_H8); }
    SEAM(1);
    for (int l = 0; l < DEPTH; ++l) {
        const int pb = 2 + 8 * l;
        if (IN(pb + 0)) REP(0) {
            Frame F = make_frame(lds_raw); unsigned char* ws = F.ws;
            pg8::Gemm g{(const bf16*)(ws + WS_H8), (const bf16*)(ws + WS_WIN + (size_t)l * NZP * D), D / 2, D / 2};
            pg8::StaticOrder S; S.init(T / 256, NZP / 256, F.G, (int)blockIdx.x);
            pg8::EpiZ E{(bf16*)(ws + WS_Z), ws + WS_KR, (float*)(ws + WS_RSQ), (float*)(ws + WS_RSKV), (const float*)(ws + WS_COS), (const float*)(ws + WS_SIN), ws + WS_CQ8, ws + WS_CKV8};
            pg8::gemm_phase<pg8::EpiZ, pg8::StaticOrder, false, true, false, 1>(F.lds, g, S, E, F.tid);
        }
        SEAM(pb + 0);
        if (IN(pb + 1)) REP(1) {
            int par_; { Frame F0 = make_frame(lds_raw); par_ = F0.vcu & 1; }
#pragma unroll 1
            for (int st = 0; st < 3; ++st) {
                const int job = par_ ? (st == 0 ? 2 : st - 1) : st;
                if (job == 0) REP(10) { Frame F = make_frame(lds_raw); unsigned char* ws = F.ws;
                  pg8::Gemm g{(const bf16*)(ws + WS_CQ8), (const bf16*)(ws + WS_WUQ + (size_t)l * NQ * CQP), CQP / 2, CQP / 2};
                  pg8::StaticOrder S; S.init(T / 256, NQ / 256, F.G, (int)blockIdx.x);
                  pg8::EpiQ E{ws + WS_Q, (const float*)(ws + WS_RSQ), (const float*)(ws + WS_COS), (const float*)(ws + WS_SIN)};
                  pg8::gemm_phase<pg8::EpiQ, pg8::StaticOrder, false, true>(F.lds, g, S, E, F.tid); }
                else if (job == 1) REP(11) { Frame F = make_frame(lds_raw); unsigned char* ws = F.ws;
                  pg8::Gemm g{(const bf16*)(ws + WS_CKV8), (const bf16*)(ws + WS_WUKV + (size_t)l * NKV * KVL), KVL / 2, KVL / 2};
                  pg8::StaticOrder S; S.init(T / 256, NKV / 256, F.G, (int)blockIdx.x);
                  pg8::EpiKV E{ws + WS_KN, ws + WS_V, (const float*)(ws + WS_RSKV)};
                  pg8::gemm_phase<pg8::EpiKV, pg8::StaticOrder, false, true, true>(F.lds, g, S, E, F.tid); }
                else REP(12) { Frame F = make_frame(lds_raw); unsigned char* ws = F.ws;
                  pool_phase(F, (const bf16*)(ws + WS_Z), (const bf16*)(ws + WS_WPOOL) + (size_t)l * 4 * 256 * 128, (bf16*)(ws + WS_PO)); }
                asm volatile("s_waitcnt vmcnt(0) lgkmcnt(0)" ::: "memory"); __syncthreads();
            }
        }
        SEAM(pb + 1);
        if (IN(pb + 2)) REP(2) {
            Frame F = make_frame(lds_raw); unsigned char* ws = F.ws;
            const att::Tensors Tn{ws + WS_Q, ws + WS_KN, ws + WS_KR, ws + WS_V, (const bf16*)(ws + WS_Z), (const bf16*)(ws + WS_PO), (bf16*)(ws + WS_MIX)};
            KArgs ap = kargs();
            const float* wgu_l = INP(17) + (size_t)l * NE * D * 2 * DFF; const float* wdn_l = INP(19) + (size_t)l * NE * DFF * D;
            unsigned char* wgu8 = ws + WS_WGU + (size_t)l * NE * 2 * DFF * D; unsigned char* wdn8 = ws + WS_WDN + (size_t)l * NE * D * DFF;
            auto tr = [=](int strip, LAS char* scrb, int lane) {
                if (strip < NE * (2 * DFF / 32)) { const int e = strip / (2 * DFF / 32), nb = strip % (2 * DFF / 32);
                    tr_strip8(wgu_l + (size_t)e * D * 2 * DFF, D, 2 * DFF, wgu8 + (size_t)e * 2 * DFF * D, MapGu(), W8_SCALE, scrb, nb, lane); }
                else { const int s2 = strip - NE * (2 * DFF / 32), e = s2 / (D / 32), nb = s2 % (D / 32);
                    tr_strip8(wdn_l + (size_t)e * DFF * D, DFF, D, wdn8 + (size_t)e * D * DFF, MapId(), W8_SCALE, scrb, nb, lane); } };
            att::attn_phase((LAS char*)F.lds, Tn, F.vcu, F.tid, F.ctl + CW_ATTQ + l * 8 * 16, F.ctl + CW_CONV + l * 16, tr);
        }
        SEAM(pb + 2);
        if (IN(pb + 3)) REP(3) {
            Frame F = make_frame(lds_raw); unsigned char* ws = F.ws; KArgs ap = kargs();
            pg8::Gemm g{(const bf16*)(ws + WS_MIX), (const bf16*)(ws + WS_WOUT) + (size_t)l * D * D, D, D};
            pg8::StaticOrder S; S.init(T / 256, D / 256, F.G, (int)blockIdx.x);
            pg8::EpiOut E{(bf16*)(ws + WS_X1), (const float*)(ws + WS_MOD) + (size_t)l * 2 * 6 * D + 2 * D};
            pg8::gemm_phase<pg8::EpiOut, pg8::StaticOrder, false, false, false, 1>(F.lds, g, S, E, F.tid);
        }
        SEAM(pb + 3);
        if (IN(pb + 4)) {
            Frame F = make_frame(lds_raw); unsigned char* ws = F.ws; KArgs ap = kargs();
            router_phase(F, (l == 0) ? (const void*)INP(0) : (const void*)(ws + WS_X2), l != 0, (const bf16*)(ws + WS_X1), INP(6) + (size_t)l * D, (const float*)(ws + WS_MOD) + (size_t)l * 2 * 6 * D, (const bf16*)(ws + WS_WR) + (size_t)l * 64 * D, INP(16) + l * NE,
                         (bf16*)(ws + WS_H), ws + WS_H8, F.ctl + CW_CNT + l * 32 * 64, (int*)(ws + WS_SDEST), (float*)(ws + WS_SW));
        }
        SEAM(pb + 4);
        if (IN(pb + 5)) REP(5) {
            Frame F = make_frame(lds_raw); unsigned char* ws = F.ws; KArgs ap = kargs();
            const int ntr = moe_tables(F, F.ctl + CW_CNT + l * 32 * 64);
            pg8::Gemm g{(const bf16*)(ws + WS_H8), (const bf16*)(ws + WS_WGU + (size_t)l * NE * 2 * DFF * D), D / 2, D / 2};
            pg8::MoeOrder S; S.nM = ntr; S.nN = 8; S.nwg = ntr * 8; S.G = F.G; S.c = (int)blockIdx.x;
            S.tinfo = (const LAS int*)(F.lds + TAB_OFF) + 68; S.cnt = (const LAS int*)(F.lds + TAB_OFF); S.sdest = (const int*)(ws + WS_SDEST);
            pg8::EpiGU E{ws + WS_ACT, INP(18) + (size_t)l * NE * 2 * DFF};
            pg8::gemm_phase<pg8::EpiGU, pg8::MoeOrder, true, true>(F.lds, g, S, E, F.tid);
        }
        SEAM(pb + 5);
        if (IN(pb + 6)) REP(6) {
            Frame F = make_frame(lds_raw); unsigned char* ws = F.ws; KArgs ap = kargs();
            const int ntr = moe_tables(F, F.ctl + CW_CNT + l * 32 * 64);
            pg8::Gemm g{(const bf16*)(ws + WS_ACT), (const bf16*)(ws + WS_WDN + (size_t)l * NE * D * DFF), DFF / 2, DFF / 2};
            pg8::MoeOrder S; S.nM = ntr; S.nN = 4; S.nwg = ntr * 4; S.G = F.G; S.c = (int)blockIdx.x;
            S.tinfo = (const LAS int*)(F.lds + TAB_OFF) + 68; S.cnt = (const LAS int*)(F.lds + TAB_OFF); S.sdest = (const int*)(ws + WS_SDEST);
            pg8::EpiDown E{ws + WS_Y, INP(20) + (size_t)l * NE * D, (const int*)(ws + WS_SDEST), (const float*)(ws + WS_SW)};
            pg8::gemm_phase<pg8::EpiDown, pg8::MoeOrder, false, true, false, 2>(F.lds, g, S, E, F.tid);
        }
        SEAM(pb + 6);
        if (IN(pb + 7)) REP(7) {
            Frame F = make_frame(lds_raw); unsigned char* ws = F.ws; KArgs ap = kargs();
            const bool lastl = (l == DEPTH - 1); const int ln = lastl ? l : l + 1;
            combine_phase(F, (l == 0) ? (const void*)INP(0) : (const void*)(ws + WS_X2), l != 0, (const bf16*)(ws + WS_X1), ws + WS_Y, (const float*)(ws + WS_MOD) + (size_t)l * 2 * 6 * D, (bf16*)(ws + WS_X2), lastl,
                          INP(5) + (size_t)ln * D, (const float*)(ws + WS_MOD) + (size_t)ln * 2 * 6 * D, ws + WS_H8, INP(21), ap->out);
        }
        SEAM(pb + 7);
    }
#undef IN
#undef SEAM
}

extern "C" void kernel_launch(void* const* d_in, const int* in_sizes, int n_in, void* d_out, int out_size, void* d_ws, size_t ws_size, hipStream_t stream) {
    static int grid = 0;
    if (grid == 0) {
        if (n_in != 22 || in_sizes[0] != T * D || out_size != T * D || ws_size < WS_END) {
            fprintf(stderr, "kernel_launch: unexpected shapes (n_in %d, in0 %d, out %d, ws %zu < %zu)\n", n_in, n_in > 0 ? in_sizes[0] : -1, out_size, ws_size, (size_t)WS_END); grid = -1; return; }
        int dev = 0, cus = 0, per_cu = 0;
        if (hipGetDevice(&dev) != hipSuccess || hipDeviceGetAttribute(&cus, hipDeviceAttributeMultiprocessorCount, dev) != hipSuccess) { grid = -1; return; }
        if (hipFuncSetAttribute((const void*)fwd_kernel, hipFuncAttributeMaxDynamicSharedMemorySize, LDS_BYTES) != hipSuccess) { fprintf(stderr, "kernel_launch: hipFuncSetAttribute failed\n"); grid = -1; return; }
        if (hipOccupancyMaxActiveBlocksPerMultiprocessor(&per_cu, (const void*)fwd_kernel, NTHREADS, LDS_BYTES) != hipSuccess || per_cu < 1)
            fprintf(stderr, "kernel_launch: occupancy query reports %d\n", per_cu);
        (void)hipGetLastError();
        grid = cus;
    }
    if (grid < 0) return;
    if (hipMemsetAsync((char*)d_ws + WS_CTL, 0, CTL_ZERO_BYTES, stream) != hipSuccess) return;
    Args a{};
    for (int i = 0; i < 22; ++i) a.in[i] = d_in[i];
    a.out = (float*)d_out; a.ws = (unsigned char*)d_ws;
    if (N_LAUNCHES == 1) {
        a.ph_lo = 0; a.ph_hi = NPHASE;
        hipLaunchKernelGGL(fwd_kernel, dim3(grid), dim3(NTHREADS), LDS_BYTES, stream, a);
    } else {
        for (int p = 0; p < NPHASE; ++p) { a.ph_lo = p; a.ph_hi = p + 1; hipLaunchKernelGGL(fwd_kernel, dim3(grid), dim3(NTHREADS), LDS_BYTES, stream, a); }
    }
}
```
